# Optimizing an MI355X kernel written in HIP

```python
import jax, jax.numpy as jnp
from jax import lax
import numpy as np


D_MODEL = 1024
BATCH = 8
SEQ = 8192
DEPTH = 4

HEAD_DIM = 64
SWA_Q_HEADS = 6
SWA_KV_HEADS = 2
SWA_WINDOW = 128
SB_HEADS = 4
RET_HEADS = 6
RET_CHUNK = 128
BLOCK = 128
ROPE_THETA = 10000.0
D_FF = 4 * D_MODEL
NORM_EPS = 1e-6

SWA_Q_W = SWA_Q_HEADS * HEAD_DIM
SWA_KV_W = SWA_KV_HEADS * HEAD_DIM
SB_W = SB_HEADS * HEAD_DIM
RET_W = RET_HEADS * HEAD_DIM
MIX_W = SWA_Q_W + SB_W + RET_W
IN_W = SWA_Q_W + 2 * SWA_KV_W + 3 * SB_W + 4 * RET_W
IN_SPLITS = np.cumsum([SWA_Q_W, SWA_KV_W, SWA_KV_W, SB_W, SB_W, SB_W, RET_W, RET_W, RET_W]).tolist()

kernel_name = 'hybrid_swa_stickbreak_retention_block'


def rms_norm(x, gain):
    xf = x.astype(jnp.float32)
    y = xf * lax.rsqrt(jnp.mean(xf * xf, axis=-1, keepdims=True) + NORM_EPS)
    return (y * gain.astype(jnp.float32)).astype(x.dtype)


def rope_tables(positions):
    inv_freq = ROPE_THETA ** (-jnp.arange(0, HEAD_DIM, 2, dtype=jnp.float32) / HEAD_DIM)
    ang = positions.astype(jnp.float32)[:, None] * inv_freq[None, :]
    return jnp.cos(ang), jnp.sin(ang)


def apply_rope(x, cos, sin):
    x1, x2 = jnp.split(x.astype(jnp.float32), 2, axis=-1)
    c = cos[None, :, None, :]
    s = sin[None, :, None, :]
    return jnp.concatenate([x1 * c - x2 * s, x1 * s + x2 * c], axis=-1).astype(x.dtype)


def swa_sink_attention(q, k, v, sinks):
    b, s, hq, hd = q.shape
    nb = s // BLOCK
    g = hq // SWA_KV_HEADS
    qb = q.reshape(b, nb, BLOCK, SWA_KV_HEADS, g, hd)

    def band(t):
        tb = t.reshape(b, nb, BLOCK, SWA_KV_HEADS, hd)
        prev = jnp.pad(tb, ((0, 0), (1, 0), (0, 0), (0, 0), (0, 0)))[:, :-1]
        return jnp.concatenate([prev, tb], axis=2)

    kb, vb = band(k), band(v)
    scores = jnp.einsum('bnqhgd,bnkhd->bnhgqk', qb, kb,
                        preferred_element_type=jnp.float32) * (hd ** -0.5)
    qi = jnp.arange(BLOCK)[:, None] + BLOCK
    ki = jnp.arange(2 * BLOCK)[None, :]
    rel = qi - ki
    in_window = (rel >= 0) & (rel < SWA_WINDOW)
    key_abs = jnp.arange(nb)[:, None, None] * BLOCK + ki[None] - BLOCK
    valid = in_window[None] & (key_abs >= 0)
    scores = jnp.where(valid[None, :, None, None], scores, -jnp.inf)
    sink = sinks.astype(jnp.float32).reshape(SWA_KV_HEADS, g)[None, None, :, :, None, None]
    sink = jnp.broadcast_to(sink, scores.shape[:-1] + (1,))
    probs = jax.nn.softmax(jnp.concatenate([scores, sink], axis=-1), axis=-1)[..., :-1]
    out = jnp.einsum('bnhgqk,bnkhd->bnqhgd', probs.astype(v.dtype), vb)
    return out.reshape(b, s, hq * hd)


def stick_breaking_attention(q, k, v):
    b, s, h, hd = q.shape
    nb = s // BLOCK
    qb = jnp.moveaxis(q.reshape(b, nb, BLOCK, h, hd), 1, 0)
    kpos = jnp.arange(s)

    def one_block(args):
        qblk, i = args
        z = jnp.einsum('bqhd,bkhd->bhqk', qblk, k,
                       preferred_element_type=jnp.float32) * (hd ** -0.5)
        qpos = i * BLOCK + jnp.arange(BLOCK)
        strict = kpos[None, :] < qpos[:, None]
        log_beta = jax.nn.log_sigmoid(z)
        log_1m = jnp.where(strict, jax.nn.log_sigmoid(-z), 0.0)
        tail = lax.cumsum(log_1m, axis=3, reverse=True) - log_1m
        w = jnp.where(strict, jnp.exp(log_beta + tail), 0.0)
        return jnp.einsum('bhqk,bkhd->bqhd', w.astype(v.dtype), v)

    out = lax.map(one_block, (qb, jnp.arange(nb)))
    return jnp.moveaxis(out, 0, 1).reshape(b, s, h * hd)


def retention(q, k, v, gate, gn_gain):
    b, s, h, hd = q.shape
    nc = s // RET_CHUNK
    log_gamma = jnp.log1p(-(2.0 ** (-5.0 - jnp.arange(h, dtype=jnp.float32))))
    f = lambda t: t.astype(jnp.float32).reshape(b, nc, RET_CHUNK, h, hd)
    qc, kc, vc = f(q), f(k) * (hd ** -0.5), f(v)
    pos = jnp.arange(RET_CHUNK, dtype=jnp.float32)
    rel = pos[:, None] - pos[None, :]
    decay = jnp.where(rel[None] >= 0,
                      jnp.exp(jnp.maximum(rel, 0.0)[None] * log_gamma[:, None, None]), 0.0)
    intra = jnp.einsum('bnqhd,bnkhd->bnhqk', qc, kc) * decay[None, None]
    o_intra = jnp.einsum('bnhqk,bnkhd->bnqhd', intra, vc)
    k_dec = jnp.exp((RET_CHUNK - 1 - pos)[:, None] * log_gamma[None, :])
    kv = jnp.einsum('bnkhd,bnkhe->nbhde', kc * k_dec[None, None, :, :, None], vc)
    chunk_decay = jnp.exp(RET_CHUNK * log_gamma)[None, :, None, None]

    def step(state, kv_n):
        return chunk_decay * state + kv_n, state

    _, prev_states = lax.scan(step, jnp.zeros((b, h, hd, hd), jnp.float32), kv)
    q_dec = jnp.exp((pos + 1.0)[:, None] * log_gamma[None, :])
    o_cross = jnp.einsum('bnqhd,nbhde->bnqhe', qc * q_dec[None, None, :, :, None], prev_states)
    o = (o_intra + o_cross).reshape(b, s, h, hd)
    mu = jnp.mean(o, axis=-1, keepdims=True)
    var = jnp.mean(jnp.square(o - mu), axis=-1, keepdims=True)
    o = (o - mu) * lax.rsqrt(var + NORM_EPS) * gn_gain.astype(jnp.float32).reshape(h, hd)
    o = jax.nn.silu(gate.astype(jnp.float32)) * o
    return o.reshape(b, s, h * hd).astype(q.dtype)


def hybrid_layer(x, cos, sin, w_in, w_out, sinks, branch_gain, w_up, w_down,
                 g_mix_pre, g_mix_post, g_mlp_pre, g_mlp_post):
    b, s, _ = x.shape
    heads = lambda t, n: t.reshape(b, s, n, HEAD_DIM)
    hn = rms_norm(x, g_mix_pre)
    proj = jnp.einsum('bsd,de->bse', hn, w_in)
    qa, ka, va, qb, kb, vb, qc, kc, vc, gc = jnp.split(proj, IN_SPLITS, axis=-1)
    qa = apply_rope(heads(qa, SWA_Q_HEADS), cos, sin)
    ka = apply_rope(heads(ka, SWA_KV_HEADS), cos, sin)
    out_a = swa_sink_attention(qa, ka, heads(va, SWA_KV_HEADS), sinks)
    out_b = stick_breaking_attention(heads(qb, SB_HEADS), heads(kb, SB_HEADS), heads(vb, SB_HEADS))
    qc = apply_rope(heads(qc, RET_HEADS), cos, sin)
    kc = apply_rope(heads(kc, RET_HEADS), cos, sin)
    ga = branch_gain[:SWA_Q_W]
    gb = branch_gain[SWA_Q_W:SWA_Q_W + SB_W]
    gcn = branch_gain[SWA_Q_W + SB_W:]
    out_c = retention(qc, kc, heads(vc, RET_HEADS), heads(gc, RET_HEADS), gcn)
    mixed = jnp.concatenate([rms_norm(out_a, ga), rms_norm(out_b, gb), out_c], axis=-1)
    y = jnp.einsum('bse,ed->bsd', mixed, w_out)
    x = x + rms_norm(y, g_mix_post)
    hm = jnp.einsum('bsd,df->bsf', rms_norm(x, g_mlp_pre), w_up)
    hm = jnp.square(jax.nn.relu(hm))
    y = jnp.einsum('bsf,fd->bsd', hm, w_down)
    return x + rms_norm(y, g_mlp_post)


def setup_inputs(seed: int = 0) -> dict:
    key = jax.random.key(seed)
    ks = jax.random.split(key, 12)
    nrm = lambda k, shape, scale: jax.random.normal(k, shape, jnp.float32) * scale
    gain = lambda k, shape: 1.0 + 0.05 * jax.random.normal(k, shape, jnp.float32)
    return {
        'x': nrm(ks[0], (BATCH, SEQ, D_MODEL), 1.0),
        'positions': jnp.arange(SEQ, dtype=jnp.int32),
        'w_in': nrm(ks[1], (DEPTH, D_MODEL, IN_W), D_MODEL ** -0.5),
        'w_out': nrm(ks[2], (DEPTH, MIX_W, D_MODEL), MIX_W ** -0.5),
        'sinks': nrm(ks[3], (DEPTH, SWA_Q_HEADS), 0.5),
        'branch_gain': gain(ks[4], (DEPTH, MIX_W)),
        'w_up': nrm(ks[5], (DEPTH, D_MODEL, D_FF), D_MODEL ** -0.5),
        'w_down': nrm(ks[6], (DEPTH, D_FF, D_MODEL), D_FF ** -0.5),
        'norm_mix_pre': gain(ks[7], (DEPTH, D_MODEL)),
        'norm_mix_post': gain(ks[8], (DEPTH, D_MODEL)),
        'norm_mlp_pre': gain(ks[9], (DEPTH, D_MODEL)),
        'norm_mlp_post': gain(ks[10], (DEPTH, D_MODEL)),
    }


def reference(x, positions, w_in, w_out, sinks, branch_gain, w_up, w_down,
              norm_mix_pre, norm_mix_post, norm_mlp_pre, norm_mlp_post):
    cos, sin = rope_tables(positions)
    for layer in range(DEPTH):
        x = hybrid_layer(x, cos, sin, w_in[layer], w_out[layer], sinks[layer], branch_gain[layer],
                         w_up[layer], w_down[layer], norm_mix_pre[layer], norm_mix_post[layer],
                         norm_mlp_pre[layer], norm_mlp_post[layer])
    return x
```

```cpp
#include <hip/hip_runtime.h>
#include <hip/hip_cooperative_groups.h>
#include <cstdio>
#include <cstdint>
namespace cg = cooperative_groups;
#define PG8_SP2 true
#define PG8_ALIGN true
constexpr int D_MODEL = 1024, BATCH = 8, SEQ = 8192, DEPTH = 4, M_TOK = BATCH * SEQ, D_FF = 4096;
constexpr int IN_W = 2944, PW = 3072;
constexpr int C_QA = 0, C_KA = 384, C_VA = 512, C_QB = 640, C_KB = 896, C_VB = 1152, C_QC = 1408, C_KC = 1792, C_VC = 2176, C_GC = 2560;
constexpr float NORM_EPS = 1e-6f;
constexpr float SB_THR = -36.0f;
constexpr int NWAVES = 8, NTHREADS = 512;
constexpr int LDS_BYTES = 155648;
constexpr size_t MiB = 1u << 20;
constexpr size_t WS_ROPE = 1 * MiB;
constexpr size_t WS_W = 4 * MiB;
constexpr size_t W_LAYER = 24 * MiB, W_OUT_OFF = 6 * MiB, W_UP_OFF = 8 * MiB, W_DOWN_OFF = 16 * MiB;
constexpr size_t WS_CNT = 65536;
constexpr size_t WS_PS1 = 100 * MiB;
constexpr size_t WS_PS2 = 101 * MiB;
constexpr size_t WS_GAIN = 102 * MiB;
constexpr size_t WS_XN = 104 * MiB;
constexpr size_t WS_MIXED = 232 * MiB;
constexpr size_t WS_Y = 232 * MiB;
constexpr size_t WS_H = 360 * MiB;
constexpr size_t WS_PROJ = 360 * MiB;
constexpr size_t WS_KV = 744 * MiB;
constexpr size_t WS_XB = 872 * MiB;
constexpr size_t WS_END = 1000 * MiB;

__device__ __forceinline__ float shx(float v, int msk) { int l = __builtin_amdgcn_mbcnt_hi(~0u, __builtin_amdgcn_mbcnt_lo(~0u, 0u)); asm volatile("" : "+v"(l)); return __int_as_float(__builtin_amdgcn_ds_bpermute((l ^ msk) << 2, __float_as_int(v))); }
namespace pg8 {
#define PG8_LAS __attribute__((address_space(3)))
typedef unsigned short bf16_t;
typedef short bf16x8 __attribute__((ext_vector_type(8)));
typedef float f32x4 __attribute__((ext_vector_type(4)));
typedef unsigned u32x4 __attribute__((ext_vector_type(4)));
constexpr int BM = 256, BK = 64, HALF = 128, HTB = HALF * BK * 2  , STAGE_BYTES = 8 * HTB, NXCD = 8, WGM = 8;

__host__ __device__ __forceinline__ int lds_byte(int r, int c) { const int st = (r >> 4) * 2 + (c >> 5), rr = r & 15, cc = c & 31, ob = rr * 64 + cc * 2; return st * 1024 + (ob ^ (((ob >> 9) & 1) << 5)); }
__host__ __device__ __forceinline__ void stage_rc(int b, int& R, int& C) { const int st = b / 1024, sb = b % 1024, swz = sb ^ (((sb >> 9) & 1) << 5); R = (st >> 1) * 16 + swz / 64; C = (st & 1) * 32 + (swz % 64) / 2; }
__host__ __device__ __forceinline__ int perm32(int rho) { const int n = rho >> 4, i = rho & 15; return 8 * (i >> 2) + 4 * n + (i & 3); }

struct Unit { int pm, pn; };
struct Gemm { const bf16_t* A; const bf16_t* Bt; int M, N, K; };

struct StaticOrder {
    int nM, nN, nwg, G, c;
    __host__ __device__ void init(int M, int N, int G_, int c_) { nM = M / BM; nN = N / BM; nwg = nM * nN; G = G_; c = c_; }
    __host__ __device__ bool next(int i, Unit& u) const {
        const long L = (long)i * G + c; if (L >= nwg) return false;
        int wgid = (int)L; { const int q = nwg / NXCD, r = nwg % NXCD, xcd = wgid % NXCD, off = wgid / NXCD; wgid = (xcd < r ? xcd * (q + 1) : r * (q + 1) + (xcd - r) * q) + off; }
        const int nig = WGM * nN, gid = wgid / nig, fm = gid * WGM, gsz = (nM - fm) < WGM ? (nM - fm) : WGM;
        u.pm = fm + ((wgid % nig) % gsz); u.pn = (wgid % nig) / gsz; return true;
    }
    __device__ __forceinline__ void a_ready(const Unit&) const {}
    __device__ __forceinline__ void done(const Unit&) const {}
};
typedef __bf16 bf16v2_t __attribute__((ext_vector_type(2)));
typedef float f32v2_t __attribute__((ext_vector_type(2)));
typedef unsigned u32x2 __attribute__((ext_vector_type(2)));
__device__ __forceinline__ unsigned pk2(float lo, float hi) { f32v2_t v = {lo, hi}; bf16v2_t b = __builtin_convertvector(v, bf16v2_t); return __builtin_bit_cast(unsigned, b); }
template <int ACT> struct EpiPlain {
    static constexpr bool PERM = true, AFTER_DRAIN = false;
    bf16_t* O; int ldc;
    __device__ __forceinline__ void operator()(const f32x4 (&acc)[2][2][4][2], const Unit& u, int wr, int wc, int fr, int fq) const {
        const int row0 = u.pm * BM + wr * 64 + fr, col0 = u.pn * BM + wc * 32 + 8 * fq;
#pragma unroll
        for (int ai = 0; ai < 2; ++ai)
#pragma unroll
            for (int m = 0; m < 4; ++m) { bf16_t* rowp = O + (size_t)(row0 + ai * HALF + m * 16) * ldc + col0;
#pragma unroll
                for (int bj = 0; bj < 2; ++bj) { f32x4 v0 = acc[ai][bj][m][0], v1 = acc[ai][bj][m][1];
                    if (ACT == 1) {
#pragma unroll
                        for (int j = 0; j < 4; ++j) { const float a = fmaxf(v0[j], 0.f), b = fmaxf(v1[j], 0.f); v0[j] = a * a; v1[j] = b * b; } }
                    u32x4 w; w.x = pk2(v0[0], v0[1]); w.y = pk2(v0[2], v0[3]); w.z = pk2(v1[0], v1[1]); w.w = pk2(v1[2], v1[3]);
                    *(u32x4*)(rowp + bj * HALF) = w; } }
    }
};
struct EpiRope {
    static constexpr bool PERM = true, AFTER_DRAIN = false;
    bf16_t* O; int ldc; const float* cs; const float* sn; int seq_mask;
    __device__ __forceinline__ void operator()(const f32x4 (&acc)[2][2][4][2], const Unit& u, int wr, int wc, int fr, int fq) const {
        const int row0 = u.pm * BM + wr * 64 + fr, col0 = u.pn * BM + wc * 32 + 8 * fq;
        const int ci = 4 * (wc & 1) + fq;
        bool rope[2];
#pragma unroll
        for (int bj = 0; bj < 2; ++bj) { const int head = 4 * u.pn + 2 * bj + (wc >> 1); rope[bj] = (head < 8) || (head >= 22 && head < 34); }
        const bool anyrope = rope[0] || rope[1];
#pragma unroll
        for (int ai = 0; ai < 2; ++ai)
#pragma unroll
            for (int m = 0; m < 4; ++m) { const int row = row0 + ai * HALF + m * 16; bf16_t* rowp = O + (size_t)row * ldc + col0;
                f32x4 c4 = {1.f, 1.f, 1.f, 1.f}, s4 = {0.f, 0.f, 0.f, 0.f};
                if (anyrope) { const int s = row & seq_mask; c4 = *(const f32x4*)(cs + s * 32 + 4 * ci); s4 = *(const f32x4*)(sn + s * 32 + 4 * ci); }
#pragma unroll
                for (int bj = 0; bj < 2; ++bj) { f32x4 v0 = acc[ai][bj][m][0], v1 = acc[ai][bj][m][1];
                    if (rope[bj]) { const f32x4 y0 = v0 * c4 - v1 * s4, y1 = v0 * s4 + v1 * c4; v0 = y0; v1 = y1; }
                    u32x4 w; w.x = pk2(v0[0], v0[1]); w.y = pk2(v0[2], v0[3]); w.z = pk2(v1[0], v1[1]); w.w = pk2(v1[2], v1[3]);
                    *(u32x4*)(rowp + bj * HALF) = w; } }
    }
};

#define PG8_RLX_AGENT __ATOMIC_RELAXED, __HIP_MEMORY_SCOPE_AGENT
struct EpiAny {
    static constexpr bool PERM = true, AFTER_DRAIN = false;
    unsigned char* ws; const float* xin; float* outp; int mode; int l;
    __device__ __forceinline__ void prime(int pm, PG8_LAS unsigned char* lds, int tid) const {
        if (mode >= 3) return;
        if (tid < 256) { const f32x4 p = *(const f32x4*)((const float*)(ws + WS_PS2) + (size_t)(pm * BM + tid) * 4);
            ((PG8_LAS float*)(lds + 140288))[tid] = rsqrtf(((p[0] + p[1]) + (p[2] + p[3])) * (1.0f / 1024.0f) + NORM_EPS); }
    }
    __device__ __forceinline__ void operator()(const f32x4 (&acc)[2][2][4][2], const Unit& u, int wr, int wc, int fr, int fq, PG8_LAS unsigned char* lds, int wid, int lane, int next_pm, int parity) const {
        asm volatile("" : "+v"(fr), "+v"(fq));
        if (mode >= 3) { fused(acc, u, wr, wc, fr, fq, lds, wid, lane); return; }
        bf16_t* O = (bf16_t*)(ws + (mode == 1 ? WS_H : WS_PROJ)); const int ldc = (mode == 1) ? D_FF : PW, seq_mask = SEQ - 1;
        const float* cs = (const float*)(ws + WS_ROPE); const float* sn = cs + SEQ * 32; const float* rowss = (const float*)(ws + WS_PS2); const float eps = NORM_EPS;
        PG8_LAS float* RSC = (PG8_LAS float*)(lds + 140288); const int tid = wid * 64 + lane;
        f32x4 pnext = {0.f, 0.f, 0.f, 0.f};
        if (tid < 256 && next_pm >= 0) pnext = *(const f32x4*)(rowss + (size_t)(next_pm * BM + tid) * 4);
        const int row0 = u.pm * BM + wr * 64 + fr, col0 = u.pn * BM + wc * 32 + 8 * fq;
        const int ci = 4 * (wc & 1) + fq;
        bool rope[2];
#pragma unroll
        for (int bj = 0; bj < 2; ++bj) { const int head = 4 * u.pn + 2 * bj + (wc >> 1); rope[bj] = (mode == 2) && ((head < 8) || (head >= 22 && head < 34)); }
        const bool anyrope = rope[0] || rope[1];
#pragma unroll
        for (int ai = 0; ai < 2; ++ai) {
            f32x4 c4[4], s4[4]; float rsc[4];
#pragma unroll
            for (int m = 0; m < 4; ++m) { c4[m] = (f32x4){1.f, 1.f, 1.f, 1.f}; s4[m] = (f32x4){0.f, 0.f, 0.f, 0.f}; rsc[m] = 1.f; }
#pragma unroll
            for (int m = 0; m < 4; ++m) rsc[m] = RSC[parity * 256 + ai * HALF + wr * 64 + m * 16 + fr];
            if (anyrope) {
#pragma unroll
                for (int m = 0; m < 4; ++m) { const int s = (row0 + ai * HALF + m * 16) & seq_mask; c4[m] = *(const f32x4*)(cs + s * 32 + 4 * ci); s4[m] = *(const f32x4*)(sn + s * 32 + 4 * ci); } }
#pragma unroll
            for (int m = 0; m < 4; ++m) { const int row = row0 + ai * HALF + m * 16; bf16_t* rowp = O + (size_t)row * ldc + col0;
#pragma unroll
                for (int bj = 0; bj < 2; ++bj) { f32x4 v0 = acc[ai][bj][m][0] * rsc[m], v1 = acc[ai][bj][m][1] * rsc[m];
                    if (rope[bj]) { const f32x4 y0 = v0 * c4[m] - v1 * s4[m], y1 = v0 * s4[m] + v1 * c4[m]; v0 = y0; v1 = y1; }
                    if (mode == 1) {
#pragma unroll
                        for (int j = 0; j < 4; ++j) { const float a = fmaxf(v0[j], 0.f), b = fmaxf(v1[j], 0.f); v0[j] = a * a; v1[j] = b * b; } }
                    u32x4 w; w.x = pk2(v0[0], v0[1]); w.y = pk2(v0[2], v0[3]); w.z = pk2(v1[0], v1[1]); w.w = pk2(v1[2], v1[3]);
                    *(u32x4*)(rowp + bj * HALF) = w; } }
            asm volatile("" ::: "memory");
        }
        if (tid < 256 && next_pm >= 0) RSC[(parity ^ 1) * 256 + tid] = rsqrtf(((pnext[0] + pnext[1]) + (pnext[2] + pnext[3])) * (1.0f / 1024.0f) + eps);
    }
    __device__ __forceinline__ void fused(const f32x4 (&acc)[2][2][4][2], const Unit& u, int wr, int wc, int fr, int fq, PG8_LAS unsigned char* lds, int wid, int lane) const {
        asm volatile("" : "+v"(fr), "+v"(fq), "+v"(lane));
        const bool last = (mode == 4) && (l + 1 == DEPTH);
        bf16_t* xb = (bf16_t*)(ws + WS_XB); float* outf = last ? outp : nullptr;
        const float* gains = (const float*)(ws + WS_GAIN);
        const float* gpost = gains + (l * 4 + (mode == 3 ? 1 : 3)) * D_MODEL;
        float* ps1 = (float*)(ws + WS_PS1); float* ps2 = (float*)(ws + WS_PS2); unsigned* cnt = (unsigned*)(ws + WS_CNT) + (size_t)(2 * l + (mode == 4 ? 1 : 0)) * 256 * 16; const float eps = NORM_EPS;
        PG8_LAS float* P1 = (PG8_LAS float*)(lds + 131072);
        PG8_LAS float* S1 = (PG8_LAS float*)(lds + 131072 + 4096);
        PG8_LAS float* P2 = (PG8_LAS float*)(lds + 131072 + 5120);
        const int tid = wid * 64 + lane;
#pragma unroll
        for (int ai = 0; ai < 2; ++ai)
#pragma unroll
            for (int m = 0; m < 4; ++m) { float s = 0.f;
#pragma unroll
                for (int bj = 0; bj < 2; ++bj)
#pragma unroll
                    for (int n = 0; n < 2; ++n) { const f32x4 x = acc[ai][bj][m][n]; s += (x[0] * x[0] + x[1] * x[1]) + (x[2] * x[2] + x[3] * x[3]); }
                s += shx(s, 16); s += shx(s, 32);
                if (fq == 0) P1[(ai * HALF + wr * 64 + m * 16 + fr) * 4 + wc] = s; }
        asm volatile("s_waitcnt lgkmcnt(0)" ::: "memory"); __builtin_amdgcn_s_barrier(); asm volatile("" ::: "memory");
        if (tid < 256) { const f32x4 p = *(const PG8_LAS f32x4*)(P1 + tid * 4);
            __hip_atomic_store(ps1 + ((size_t)(u.pm * BM + tid)) * 4 + u.pn, (p[0] + p[1]) + (p[2] + p[3]), PG8_RLX_AGENT);
            asm volatile("s_waitcnt vmcnt(0)" ::: "memory");
            if (lane == 0) __hip_atomic_fetch_add(cnt + 16 * u.pm, 1u, PG8_RLX_AGENT); }
        if (wid == 0) { unsigned spins = 0;
            while ((unsigned)__builtin_amdgcn_readfirstlane((int)__hip_atomic_load(cnt + 16 * u.pm, PG8_RLX_AGENT)) < 16u) { __builtin_amdgcn_s_sleep(2); if (++spins > (1u << 21)) break; }
            __builtin_amdgcn_fence(__ATOMIC_ACQUIRE, "agent"); asm volatile("s_waitcnt vmcnt(0)" ::: "memory"); }
        asm volatile("s_waitcnt lgkmcnt(0)" ::: "memory"); __builtin_amdgcn_s_barrier(); asm volatile("" ::: "memory");
        if (tid < 256) { const float* q = ps1 + ((size_t)(u.pm * BM + tid)) * 4;
            const float t = (__hip_atomic_load(q, PG8_RLX_AGENT) + __hip_atomic_load(q + 1, PG8_RLX_AGENT)) + (__hip_atomic_load(q + 2, PG8_RLX_AGENT) + __hip_atomic_load(q + 3, PG8_RLX_AGENT));
            S1[tid] = rsqrtf(t * (1.0f / 1024.0f) + eps); }
        asm volatile("s_waitcnt lgkmcnt(0)" ::: "memory"); __builtin_amdgcn_s_barrier(); asm volatile("" ::: "memory");
        const int col0 = u.pn * BM + wc * 32 + 8 * fq;
        f32x4 g1[2][2];
#pragma unroll
        for (int bj = 0; bj < 2; ++bj)
#pragma unroll
            for (int n = 0; n < 2; ++n) { g1[bj][n] = *(const f32x4*)(gpost + col0 + bj * HALF + 4 * n); }
#pragma unroll
        for (int ai = 0; ai < 2; ++ai) {
            u32x4 xq[4][2];
#pragma unroll
            for (int m = 0; m < 4; ++m) { const size_t off = (size_t)(u.pm * BM + ai * HALF + wr * 64 + m * 16 + fr) * 1024 + col0;
#pragma unroll
                for (int bj = 0; bj < 2; ++bj) {
                    xq[m][bj] = *(const u32x4*)(xb + off + bj * HALF); } }
#pragma unroll
            for (int m = 0; m < 4; ++m) { const int rl = ai * HALF + wr * 64 + m * 16 + fr; const size_t off = (size_t)(u.pm * BM + rl) * 1024 + col0; const float rstd = S1[rl]; float s2 = 0.f;
#pragma unroll
                for (int bj = 0; bj < 2; ++bj) { f32x4 x0, x1;
                    { const u32x4 w = xq[m][bj];
                        x0 = (f32x4){__uint_as_float(w.x << 16), __uint_as_float(w.x & 0xffff0000u), __uint_as_float(w.y << 16), __uint_as_float(w.y & 0xffff0000u)};
                        x1 = (f32x4){__uint_as_float(w.z << 16), __uint_as_float(w.z & 0xffff0000u), __uint_as_float(w.w << 16), __uint_as_float(w.w & 0xffff0000u)}; }
                    f32x4 v0 = x0 + acc[ai][bj][m][0] * rstd * g1[bj][0], v1 = x1 + acc[ai][bj][m][1] * rstd * g1[bj][1];
                    if (outf) { float* op = outf + off + bj * HALF; *(f32x4*)op = v0; *(f32x4*)(op + 4) = v1; }
                    else { u32x4 w; w.x = pk2(v0[0], v0[1]); w.y = pk2(v0[2], v0[3]); w.z = pk2(v1[0], v1[1]); w.w = pk2(v1[2], v1[3]);
                        *(u32x4*)(xb + off + bj * HALF) = w;
                        v0 = (f32x4){__uint_as_float(w.x << 16), __uint_as_float(w.x & 0xffff0000u), __uint_as_float(w.y << 16), __uint_as_float(w.y & 0xffff0000u)};
                        v1 = (f32x4){__uint_as_float(w.z << 16), __uint_as_float(w.z & 0xffff0000u), __uint_as_float(w.w << 16), __uint_as_float(w.w & 0xffff0000u)};
                        s2 += ((v0[0] * v0[0] + v0[1] * v0[1]) + (v0[2] * v0[2] + v0[3] * v0[3])) + ((v1[0] * v1[0] + v1[1] * v1[1]) + (v1[2] * v1[2] + v1[3] * v1[3]));
                    } }
                if (!outf) { s2 += shx(s2, 16); s2 += shx(s2, 32); if (fq == 0) P2[rl * 4 + wc] = s2; } }
            asm volatile("" ::: "memory");
        }
        if (!outf) {
            asm volatile("s_waitcnt lgkmcnt(0)" ::: "memory"); __builtin_amdgcn_s_barrier(); asm volatile("" ::: "memory");
            if (tid < 256) { const f32x4 p = *(const PG8_LAS f32x4*)(P2 + tid * 4); ps2[((size_t)(u.pm * BM + tid)) * 4 + u.pn] = (p[0] + p[1]) + (p[2] + p[3]); } }
    }
};
template <class Epi, class Sched, bool ALIGN_EPI = false, bool SP2 = false>
__device__ __forceinline__ void gemm_phase(PG8_LAS unsigned char* lds, const Gemm g, const Sched& S, const Epi& E, const int tid) {
    const int wid = __builtin_amdgcn_readfirstlane(tid >> 6), lane = tid & 63, wr = wid >> 2, wc = wid & 3, fr = lane & 15, fq = lane >> 4;
    const int K = g.K, nt = K / BK;
    unsigned voffA[2], voffB[2];
#pragma unroll
    for (int i = 0; i < 2; ++i) { int R, C; stage_rc(tid * 16 + i * 8192, R, C); const int Rb = Epi::PERM ? ((R & ~31) + perm32(R & 31)) : R;
        voffA[i] = (unsigned)(R * K + C) * 2u; voffB[i] = (unsigned)(Rb * K + C) * 2u; }
    const size_t kstep = (size_t)(BK * 2);
    const size_t hstep = (size_t)HALF * K * 2;
    const size_t tstep = 2 * hstep;
    const unsigned ldsw = (unsigned)wid * 1024u;
    const int aoff = lds_byte(wr * 64 + fr, fq * 8), boff = lds_byte(wc * 32 + fr, fq * 8);
#define PG8_SA(b, h) (((b) * 2 + (h)) * HTB)
#define PG8_SB(b, h) ((4 + (b) * 2 + (h)) * HTB)
#define PG8_STAGE(bufoff, gbase, voff) do { _Pragma("unroll") for (int _i = 0; _i < 2; ++_i) \
        __builtin_amdgcn_global_load_lds((const unsigned*)((const char*)(gbase) + (voff)[_i]), (PG8_LAS unsigned*)(lds + (bufoff) + ldsw + _i * 8192), 16, 0, 0); } while (0)
#define PG8_LDA(dst, b, h) do { _Pragma("unroll") for (int m = 0; m < 4; ++m) _Pragma("unroll") for (int k = 0; k < 2; ++k) dst[m][k] = *(const PG8_LAS bf16x8*)(lds + PG8_SA(b, h) + aoff + m * 2048 + k * 1024); } while (0)
#define PG8_LDB(dst, b, h) do { _Pragma("unroll") for (int n = 0; n < 2; ++n) _Pragma("unroll") for (int k = 0; k < 2; ++k) dst[n][k] = *(const PG8_LAS bf16x8*)(lds + PG8_SB(b, h) + boff + n * 2048 + k * 1024); } while (0)
#define PG8_MMA(ai, bj, At, Bt) do { __builtin_amdgcn_s_setprio(1); _Pragma("unroll") for (int m = 0; m < 4; ++m) _Pragma("unroll") for (int n = 0; n < 2; ++n) _Pragma("unroll") for (int k = 0; k < 2; ++k) \
        acc[ai][bj][m][n] = __builtin_amdgcn_mfma_f32_16x16x32_bf16(Bt[n][k], At[m][k], acc[ai][bj][m][n], 0, 0, 0); __builtin_amdgcn_s_setprio(0); } while (0)
#define PG8_WAIT_V(n) asm volatile("s_waitcnt vmcnt(" #n ")" ::: "memory")
#define PG8_WAIT_L(n) asm volatile("s_waitcnt lgkmcnt(" #n ")" ::: "memory")
#define PG8_BAR __builtin_amdgcn_s_barrier()
#define PG8_SCHED __builtin_amdgcn_sched_barrier(0)
    Unit cur, nxt; int ui = 0;
    if (!S.next(0, cur)) return;
    f32x4 acc[2][2][4][2];
#pragma unroll
    for (int a = 0; a < 2; ++a)
#pragma unroll
        for (int b = 0; b < 2; ++b)
#pragma unroll
            for (int m = 0; m < 4; ++m)
#pragma unroll
                for (int n = 0; n < 2; ++n) acc[a][b][m][n] = (f32x4){0.f, 0.f, 0.f, 0.f};
    bf16x8 At[4][2], B0[2][2], B1[2][2];
    const char* cA = (const char*)g.A + (size_t)cur.pm * tstep; const char* cB = (const char*)g.Bt + (size_t)cur.pn * tstep;
    S.a_ready(cur);
    E.prime(cur.pm, lds, wid * 64 + lane);
    if constexpr (SP2) {
        PG8_STAGE(PG8_SB(0, 0), cB, voffB); PG8_STAGE(PG8_SB(0, 1), cB + hstep, voffB); PG8_STAGE(PG8_SA(0, 0), cA, voffA); PG8_STAGE(PG8_SA(0, 1), cA + hstep, voffA);
        if (wr == 1) PG8_BAR;
        PG8_WAIT_V(2); PG8_BAR;
        PG8_STAGE(PG8_SB(1, 0), cB + kstep, voffB); PG8_STAGE(PG8_SA(1, 0), cA + kstep, voffA); PG8_STAGE(PG8_SB(1, 1), cB + hstep + kstep, voffB);
        PG8_WAIT_V(6); PG8_BAR;
    } else {
        PG8_STAGE(PG8_SB(0, 0), cB, voffB); PG8_STAGE(PG8_SA(0, 0), cA, voffA); PG8_STAGE(PG8_SB(0, 1), cB + hstep, voffB); PG8_STAGE(PG8_SA(0, 1), cA + hstep, voffA);
        if (wr == 1) PG8_BAR;
        PG8_WAIT_V(4); PG8_BAR;
        PG8_STAGE(PG8_SB(1, 0), cB + kstep, voffB); PG8_STAGE(PG8_SA(1, 0), cA + kstep, voffA); PG8_STAGE(PG8_SB(1, 1), cB + hstep + kstep, voffB);
        PG8_WAIT_V(6); PG8_BAR;
    }
    for (;;) {
        const bool has_next = S.next(ui + 1, nxt);
        const char* nA = has_next ? (const char*)g.A + (size_t)nxt.pm * tstep : cA; const char* nB = has_next ? (const char*)g.Bt + (size_t)nxt.pn * tstep : cB;
        for (int t = 0; t < nt; t += 2) {
            const bool last = (t == nt - 2);
            const char* a1 = cA + (size_t)(t + 1) * kstep;
            const char* a2 = last ? nA : cA + (size_t)(t + 2) * kstep; const char* b2 = last ? nB : cB + (size_t)(t + 2) * kstep;
            const char* a3 = a2 + kstep; const char* b3 = b2 + kstep;
            if (last && has_next) S.a_ready(nxt);
            if constexpr (SP2) {
            PG8_LDB(B0, 0, 0); PG8_LDB(B1, 0, 1); PG8_SCHED; PG8_LDA(At, 0, 0); PG8_STAGE(PG8_SA(1, 1), a1 + hstep, voffA);
            PG8_WAIT_V(8); PG8_WAIT_L(0); PG8_BAR; PG8_MMA(0, 0, At, B0); PG8_MMA(0, 1, At, B1); PG8_BAR; PG8_SCHED;
            PG8_LDA(At, 0, 1); PG8_STAGE(PG8_SB(0, 0), b2, voffB); PG8_STAGE(PG8_SB(0, 1), b2 + hstep, voffB); PG8_STAGE(PG8_SA(0, 0), a2, voffA);
            PG8_WAIT_V(8); PG8_WAIT_L(0); PG8_BAR; PG8_MMA(1, 0, At, B0); PG8_MMA(1, 1, At, B1); PG8_BAR; PG8_SCHED;
            PG8_LDB(B0, 1, 0); PG8_LDB(B1, 1, 1); PG8_SCHED; PG8_LDA(At, 1, 0); PG8_STAGE(PG8_SA(0, 1), a2 + hstep, voffA);
            PG8_WAIT_V(8); PG8_WAIT_L(0); PG8_BAR; PG8_MMA(0, 0, At, B0); PG8_MMA(0, 1, At, B1); PG8_BAR; PG8_SCHED;
            PG8_LDA(At, 1, 1); PG8_STAGE(PG8_SB(1, 0), b3, voffB); PG8_STAGE(PG8_SB(1, 1), b3 + hstep, voffB); PG8_STAGE(PG8_SA(1, 0), a3, voffA);
            PG8_WAIT_V(8); PG8_WAIT_L(0); PG8_BAR; PG8_MMA(1, 0, At, B0); PG8_MMA(1, 1, At, B1); PG8_BAR; PG8_SCHED;
            } else {
            PG8_LDB(B0, 0, 0); PG8_SCHED; PG8_LDA(At, 0, 0); PG8_STAGE(PG8_SA(1, 1), a1 + hstep, voffA);
            PG8_WAIT_L(8); PG8_BAR; PG8_WAIT_L(0); PG8_MMA(0, 0, At, B0); PG8_BAR; PG8_SCHED;
            PG8_LDB(B1, 0, 1); PG8_STAGE(PG8_SB(0, 0), b2, voffB);
            PG8_BAR; PG8_WAIT_L(0); PG8_MMA(0, 1, At, B1); PG8_BAR;
            PG8_LDA(At, 0, 1); PG8_STAGE(PG8_SA(0, 0), a2, voffA);
            PG8_BAR; PG8_WAIT_L(0); PG8_MMA(1, 0, At, B0); PG8_BAR; PG8_SCHED;
            PG8_STAGE(PG8_SB(0, 1), b2 + hstep, voffB);
            PG8_WAIT_V(6); PG8_BAR; PG8_MMA(1, 1, At, B1); PG8_BAR;
            PG8_LDB(B0, 1, 0); PG8_SCHED; PG8_LDA(At, 1, 0); PG8_STAGE(PG8_SA(0, 1), a2 + hstep, voffA);
            PG8_WAIT_L(8); PG8_BAR; PG8_WAIT_L(0); PG8_MMA(0, 0, At, B0); PG8_BAR; PG8_SCHED;
            PG8_LDB(B1, 1, 1); PG8_STAGE(PG8_SB(1, 0), b3, voffB);
            PG8_BAR; PG8_WAIT_L(0); PG8_MMA(0, 1, At, B1); PG8_BAR;
            PG8_LDA(At, 1, 1); PG8_STAGE(PG8_SA(1, 0), a3, voffA);
            PG8_BAR; PG8_WAIT_L(0); PG8_MMA(1, 0, At, B0); PG8_BAR; PG8_SCHED;
            PG8_STAGE(PG8_SB(1, 1), b3 + hstep, voffB);
            PG8_WAIT_V(6); PG8_BAR; PG8_MMA(1, 1, At, B1); PG8_BAR;
            }
        }
        if constexpr (ALIGN_EPI) { if (wr == 0) PG8_BAR; }
        if constexpr (!Epi::AFTER_DRAIN) { E(acc, cur, wr, wc, fr, fq, lds, wid, lane, has_next ? nxt.pm : -1, ui & 1); S.done(cur); }
        if (!has_next) break;
#pragma unroll
        for (int a = 0; a < 2; ++a)
#pragma unroll
            for (int b = 0; b < 2; ++b)
#pragma unroll
                for (int m = 0; m < 4; ++m)
#pragma unroll
                    for (int n = 0; n < 2; ++n) acc[a][b][m][n] = (f32x4){0.f, 0.f, 0.f, 0.f};
        cur = nxt; cA = nA; cB = nB; ++ui;
        if constexpr (ALIGN_EPI) { if (wr == 1) PG8_BAR; }
    }
    PG8_WAIT_V(0);
    if constexpr (!ALIGN_EPI) { if (wr == 0) PG8_BAR; }
    PG8_BAR;
    if constexpr (Epi::AFTER_DRAIN) { E.fused(acc, cur, wr, wc, fr, fq, lds, wid, lane); S.done(cur); }
#undef PG8_SA
#undef PG8_SB
#undef PG8_STAGE
#undef PG8_LDA
#undef PG8_LDB
#undef PG8_MMA
#undef PG8_WAIT_V
#undef PG8_WAIT_L
#undef PG8_BAR
#undef PG8_SCHED
}
}
#define LAS __attribute__((address_space(3)))
typedef LAS unsigned char* ldsp;
typedef unsigned short bf16_t;
typedef short bf16x8 __attribute__((ext_vector_type(8)));
typedef short s16x4 __attribute__((ext_vector_type(4)));
typedef float f32x4 __attribute__((ext_vector_type(4)));
typedef float f32x16 __attribute__((ext_vector_type(16)));
typedef unsigned u32x4 __attribute__((ext_vector_type(4)));
typedef unsigned u32x2 __attribute__((ext_vector_type(2)));
using pg8::pk2;
#define DI __device__ __forceinline__
#define LDS_WAIT() asm volatile("s_waitcnt lgkmcnt(0)" ::: "memory")

DI f32x16 mfma32(bf16x8 a, bf16x8 b, f32x16 c) { return __builtin_amdgcn_mfma_f32_32x32x16_bf16(a, b, c, 0, 0, 0); }
DI constexpr int crow(int i, int h) { return (i & 3) + 8 * (i >> 2) + 4 * h; }
DI float bf2f(unsigned short b) { return __uint_as_float(((unsigned)b) << 16); }
DI f32x16 zero16() { f32x16 z;
#pragma unroll
  for (int i = 0; i < 16; ++i) z[i] = 0.f; return z; }
DI bf16x8 pack8(const f32x16& x, const int s) { u32x4 p; p.x = pk2(x[8 * s], x[8 * s + 1]); p.y = pk2(x[8 * s + 2], x[8 * s + 3]); p.z = pk2(x[8 * s + 4], x[8 * s + 5]); p.w = pk2(x[8 * s + 6], x[8 * s + 7]); return __builtin_bit_cast(bf16x8, p); }
DI float lg2gamma(int head) { return log2f(1.0f - exp2f(-5.0f - (float)head)); }
DI int launder(int x) { asm volatile("" : "+v"(x)); return x; }
template <int CTRL> DI float dpp_add(float v) { return v + __int_as_float(__builtin_amdgcn_update_dpp(0, __float_as_int(v), CTRL, 0xF, 0xF, true)); }
DI float wave_sum(float v) {
    v = dpp_add<0xB1>(v);
    v = dpp_add<0x4E>(v);
    v = dpp_add<0x141>(v);
    v = dpp_add<0x140>(v);
    v += __int_as_float(__builtin_amdgcn_ds_swizzle(__float_as_int(v), 0x401F));
    v += shx(v, 32);
    return v; }

#define XB_TMO      128
#define XB_XCNT(j)  (256  + 64 * (j))
#define XB_XSUB(j)  (1280 + 64 * (j))
#define XB_XGEN(j)  (2304 + 64 * (j))
#define XB_TOP      3328
#define XB_TOPGEN   3392
#define XCD_BAR_WORDS 3456
#define XB_SPIN_CAP (1u << 18)

__device__ __forceinline__ unsigned xb_ld(unsigned* p)              { return __hip_atomic_load(p, __ATOMIC_RELAXED, __HIP_MEMORY_SCOPE_AGENT); }
__device__ __forceinline__ unsigned xb_add(unsigned* p, unsigned v) { return __hip_atomic_fetch_add(p, v, __ATOMIC_RELAXED, __HIP_MEMORY_SCOPE_AGENT); }
__device__ __forceinline__ unsigned xb_xcc_id() { return (unsigned)__builtin_amdgcn_s_getreg((3 << 11) | 20) & 0xFu; }
#define XB_SPIN(cond, bar) do { unsigned _sp = 0; while (cond) { __builtin_amdgcn_s_sleep(1); \
    if ((++_sp & 255u) == 0u) { if (xb_ld(&(bar)[XB_TMO])) break; if (_sp > XB_SPIN_CAP) { atomicAdd(&(bar)[XB_TMO], 1u); break; } } } } while (0)

struct XcdBarrier {
    unsigned* bar; unsigned x;
    volatile LAS unsigned* st;
};

__device__ __forceinline__ XcdBarrier xcd_barrier_post(unsigned* bar, volatile LAS unsigned* st) {
    XcdBarrier b; b.bar = bar; b.x = xb_xcc_id(); b.st = st;
    if (threadIdx.x == 0) (void)xb_add(&bar[XB_XCNT(b.x)], 1u);
    return b;
}
__device__ __forceinline__ void xcd_barrier_complete(unsigned* bar, unsigned x, unsigned& nloc, unsigned& nx) {
    const unsigned G = gridDim.x * gridDim.y * gridDim.z;
    unsigned sum, cnt, mine, sp = 0u;
    for (;;) {
        sum = 0u; cnt = 0u; mine = 0u;
#pragma unroll
        for (unsigned j = 0; j < 16; ++j) { const unsigned c = xb_ld(&bar[XB_XCNT(j)]); sum += c; cnt += (c > 0u) ? 1u : 0u; mine = (j == x) ? c : mine; }
        if (sum == G) break;
        __builtin_amdgcn_s_sleep(1);
        if ((++sp & 255u) == 0u) { if (xb_ld(&bar[XB_TMO])) break; if (sp > XB_SPIN_CAP) { atomicAdd(&bar[XB_TMO], 1u); break; } }
    }
    nloc = mine > 0u ? mine : 1u; nx = cnt > 0u ? cnt : 1u;
}

__device__ __forceinline__ void xcd_barrier(const XcdBarrier& b) {
    asm volatile("s_waitcnt vmcnt(0)" ::: "memory");
    __syncthreads();
    if (threadIdx.x == 0) {
        unsigned* bar = b.bar;
        __builtin_amdgcn_s_waitcnt(0);
        unsigned nloc = b.st[0], nx = b.st[1];
        if (nloc == 0u) { xcd_barrier_complete(bar, b.x, nloc, nx); b.st[0] = nloc; b.st[1] = nx; }
        const unsigned old = xb_add(&bar[XB_XSUB(b.x)], 1u);
        const unsigned gen = old / nloc;
        if (old + 1u == (gen + 1u) * nloc) {
            __builtin_amdgcn_fence(__ATOMIC_RELEASE, "agent");
            asm volatile("s_waitcnt vmcnt(0)" ::: "memory");
            const unsigned og = xb_add(&bar[XB_TOP], 1u);
            const unsigned tg = og / nx;
            if (og + 1u == (tg + 1u) * nx) xb_add(&bar[XB_TOPGEN], 1u);
            else XB_SPIN(xb_ld(&bar[XB_TOPGEN]) == tg, bar);
            __builtin_amdgcn_fence(__ATOMIC_ACQUIRE, "agent");
            xb_add(&bar[XB_XGEN(b.x)], 1u);
            asm volatile("s_waitcnt vmcnt(0)" ::: "memory");
        } else {
            XB_SPIN(xb_ld(&bar[XB_XGEN(b.x)]) == gen, bar);
            __builtin_amdgcn_fence(__ATOMIC_ACQUIRE, "agent");
            asm volatile("s_waitcnt vmcnt(0)" ::: "memory");
        }
    }
    __syncthreads();
}

DI void stage_rows(ldsp dst, const bf16_t* src, size_t pitch, int nrows, int tid) {
    for (int it = tid; it < nrows * 8; it += NTHREADS) { const int r = it >> 3, c = it & 7;
        const u32x4 v = *(const u32x4*)(src + (size_t)r * pitch + c * 8);
        *(LAS u32x4*)(dst + r * 144 + c * 16) = v; }
}
template <int NT> DI void stage_tiles(ldsp lds, const int (&dstoff)[NT], const bf16_t* const (&src)[NT], const float (&lg)[NT], int tid) {
    u32x4 v[NT][2];
    const int r0 = tid >> 3, c = tid & 7;
#pragma unroll
    for (int t = 0; t < NT; ++t)
#pragma unroll
        for (int i = 0; i < 2; ++i) v[t][i] = *(const u32x4*)(src[t] + (size_t)(r0 + 64 * i) * PW + c * 8);
#pragma unroll
    for (int t = 0; t < NT; ++t)
#pragma unroll
        for (int i = 0; i < 2; ++i) { u32x4 o = v[t][i];
            if (lg[t] != 0.f) { const float sc = exp2f((float)(127 - (r0 + 64 * i)) * lg[t]);
                o.x = pk2(__uint_as_float(o.x << 16) * sc, __uint_as_float(o.x & 0xffff0000u) * sc); o.y = pk2(__uint_as_float(o.y << 16) * sc, __uint_as_float(o.y & 0xffff0000u) * sc);
                o.z = pk2(__uint_as_float(o.z << 16) * sc, __uint_as_float(o.z & 0xffff0000u) * sc); o.w = pk2(__uint_as_float(o.w << 16) * sc, __uint_as_float(o.w & 0xffff0000u) * sc); }
            *(LAS u32x4*)(lds + dstoff[t] + (r0 + 64 * i) * 144 + c * 16) = o; }
}
DI void stage_rows_scaled(ldsp dst, const bf16_t* src, size_t pitch, int nrows, int tid, float lg) {
    for (int it = tid; it < nrows * 8; it += NTHREADS) { const int r = it >> 3, c = it & 7;
        const u32x4 v = *(const u32x4*)(src + (size_t)r * pitch + c * 8); const float sc = exp2f((float)(127 - r) * lg);
        u32x4 o; o.x = pk2(__uint_as_float(v.x << 16) * sc, __uint_as_float(v.x & 0xffff0000u) * sc); o.y = pk2(__uint_as_float(v.y << 16) * sc, __uint_as_float(v.y & 0xffff0000u) * sc);
        o.z = pk2(__uint_as_float(v.z << 16) * sc, __uint_as_float(v.z & 0xffff0000u) * sc); o.w = pk2(__uint_as_float(v.w << 16) * sc, __uint_as_float(v.w & 0xffff0000u) * sc);
        *(LAS u32x4*)(dst + r * 144 + c * 16) = o; }
}
template <bool SCALE> DI void stage_T(ldsp dst, int stride, int key0, const bf16_t* src, size_t pitch, int nrows, int tid, float lg) {
    for (int it = tid; it < nrows * 8; it += NTHREADS) { const int r = it >> 3, c = it & 7;
        const u32x4 v = *(const u32x4*)(src + (size_t)r * pitch + c * 8);
        unsigned w[4] = {v.x, v.y, v.z, v.w};
        float sc = 1.f; if (SCALE) sc = exp2f((float)(127 - r) * lg);
#pragma unroll
        for (int j = 0; j < 8; ++j) { unsigned short e = (unsigned short)((j & 1) ? (w[j >> 1] >> 16) : (w[j >> 1] & 0xffffu));
            if (SCALE) { e = (unsigned short)(pk2(bf2f(e) * sc, 0.f) & 0xffffu); }
            *(LAS unsigned short*)(dst + ((8 * c + j) * stride + key0 + r) * 2) = e; } }
}
DI bf16x8 kfrag(ldsp Kb, int row, int kk, int h) { return *(const LAS bf16x8*)(Kb + row * 144 + (16 * kk + 8 * h) * 2); }
DI bf16x8 vtfrag_perm(ldsp Vb, int stride, int row, int key0, int h) {
    const s16x4 lo = *(const LAS s16x4*)(Vb + (row * stride + key0 + 4 * h) * 2), hi = *(const LAS s16x4*)(Vb + (row * stride + key0 + 8 + 4 * h) * 2);
    return __builtin_shufflevector(lo, hi, 0, 1, 2, 3, 4, 5, 6, 7); }
DI int vt_lane_off(int lane) { const int i = lane & 15; return (i >> 2) * 144 + (16 * ((lane >> 4) & 1) + 4 * (i & 3)) * 2; }
DI s16x4 tr_read(ldsp p) { return __builtin_amdgcn_ds_read_tr16_b64_v4i16((LAS s16x4*)p); }
DI bf16x8 vfrag_perm_tr(ldsp Vb, int loff, int col0, int key0, int h) {
    ldsp p = Vb + (key0 + 4 * h) * 144 + col0 * 2 + loff;
    const s16x4 lo = tr_read(p), hi = tr_read(p + 8 * 144);
    return __builtin_shufflevector(lo, hi, 0, 1, 2, 3, 4, 5, 6, 7); }
DI bf16x8 vfrag_nat_tr(ldsp Vb, int loff, int col0, int key0, int h) {
    ldsp p = Vb + (key0 + 8 * h) * 144 + col0 * 2 + loff;
    const s16x4 lo = tr_read(p), hi = tr_read(p + 4 * 144);
    return __builtin_shufflevector(lo, hi, 0, 1, 2, 3, 4, 5, 6, 7); }
DI bf16x8 vtfrag_nat(ldsp Vb, int stride, int row, int key0, int h) {
    const s16x4 lo = *(const LAS s16x4*)(Vb + (row * stride + key0 + 8 * h) * 2), hi = *(const LAS s16x4*)(Vb + (row * stride + key0 + 8 * h + 4) * 2);
    return __builtin_shufflevector(lo, hi, 0, 1, 2, 3, 4, 5, 6, 7); }

DI void swa_unit(ldsp lds, int u, const bf16_t* PROJ, bf16_t* MIXED, const float* sinks, const float* ga, int tid) {
    tid = launder(tid);
    const int b = u >> 6, nb = u & 63;
    const size_t tok0 = (size_t)b * SEQ + (size_t)nb * 128, prev0 = nb > 0 ? tok0 - 128 : tok0;
    ldsp Ks = lds, VTs = lds + 73728; LAS float* xs = (LAS float*)(lds + 147456);
    __syncthreads();
    {   const int dsto[8] = {0, 128 * 144, 36864, 36864 + 128 * 144, 73728, 73728 + 128 * 144, 73728 + 36864, 73728 + 36864 + 128 * 144};
        const bf16_t* const srcs[8] = {PROJ + prev0 * PW + C_KA, PROJ + tok0 * PW + C_KA, PROJ + prev0 * PW + C_KA + 64, PROJ + tok0 * PW + C_KA + 64,
                                       PROJ + prev0 * PW + C_VA, PROJ + tok0 * PW + C_VA, PROJ + prev0 * PW + C_VA + 64, PROJ + tok0 * PW + C_VA + 64};
        const float lgs[8] = {0.f, 0.f, 0.f, 0.f, 0.f, 0.f, 0.f, 0.f};
        stage_tiles<8>(lds, dsto, srcs, lgs, tid); }
    __syncthreads();
    const int wave = __builtin_amdgcn_readfirstlane(tid >> 6), lane = tid & 63, rt = wave & 3, hk = wave >> 2, qi = lane & 31, h = lane >> 5;
    const int qrow = 32 * rt + qi; const size_t token = tok0 + qrow;
    ldsp Kh = Ks + hk * 36864, Vh = VTs + hk * 36864; const int loff = vt_lane_off(lane);
    u32x2 Op[3][2][4]; float ssq = 0.f;
#pragma unroll
    for (int hh = 0; hh < 3; ++hh) {
        const int head = 3 * hk + hh; f32x16 O[2];
        bf16x8 q[4];
#pragma unroll
        for (int kk = 0; kk < 4; ++kk) q[kk] = *(const bf16x8*)(PROJ + token * PW + C_QA + head * 64 + 16 * kk + 8 * h);
        const float sink = sinks[head]; float mx = sink, den = 1.0f;
        O[0] = zero16(); O[1] = zero16();
#pragma unroll
        for (int ti = 0; ti < 5; ++ti) {
            f32x16 s = zero16();
#pragma unroll
            for (int kk = 0; kk < 4; ++kk) s = mfma32(kfrag(Kh, 32 * (rt + ti) + qi, kk, h), q[kk], s);
            float tm = -INFINITY;
            const int kb0 = 32 * (rt + ti) + 4 * h, lo_t = launder(max(qrow, nb > 0 ? -1 : 127) - kb0), hi_t = launder(128 + qrow - kb0);
#pragma unroll
            for (int i = 0; i < 16; ++i) { const int c = (i & 3) + 8 * (i >> 2);
                const bool valid = (c > lo_t) && (c <= hi_t);
                const float v = valid ? s[i] : -INFINITY; s[i] = v; tm = fmaxf(tm, v); }
            tm = fmaxf(tm, shx(tm, 32));
            const float mn = fmaxf(mx, tm), sc = __expf(mx - mn); mx = mn;
            float ps = 0.f;
#pragma unroll
            for (int i = 0; i < 16; ++i) { const float p = __expf(s[i] - mn); s[i] = p; ps += p; }
            den = den * sc + ps;
#pragma unroll
            for (int dd = 0; dd < 2; ++dd)
#pragma unroll
                for (int i = 0; i < 16; ++i) O[dd][i] *= sc;
#pragma unroll
            for (int s2 = 0; s2 < 2; ++s2) { const bf16x8 P = pack8(s, s2);
#pragma unroll
                for (int dd = 0; dd < 2; ++dd) O[dd] = mfma32(vfrag_perm_tr(Vh, loff, 32 * dd, 32 * (rt + ti) + 16 * s2, h), P, O[dd]); }
            asm volatile("" ::: "memory");
        }
        den += shx(den, 32) - __expf(sink - mx);
        const float inv = 1.0f / den;
#pragma unroll
        for (int dd = 0; dd < 2; ++dd)
#pragma unroll
            for (int i = 0; i < 16; ++i) { const float o = O[dd][i] * inv; O[dd][i] = o; ssq += o * o; }
#pragma unroll
        for (int dd = 0; dd < 2; ++dd)
#pragma unroll
            for (int g = 0; g < 4; ++g) { Op[hh][dd][g].x = pk2(O[dd][4 * g], O[dd][4 * g + 1]); Op[hh][dd][g].y = pk2(O[dd][4 * g + 2], O[dd][4 * g + 3]); }
    }
    ssq += shx(ssq, 32);
    if (h == 0) xs[hk * 128 + qrow] = ssq;
    __syncthreads();
    const float rstd = rsqrtf((xs[qrow] + xs[128 + qrow]) * (1.0f / 384.0f) + NORM_EPS);
#pragma unroll
    for (int hh = 0; hh < 3; ++hh)
#pragma unroll
        for (int dd = 0; dd < 2; ++dd)
#pragma unroll
            for (int g = 0; g < 4; ++g) { const int col = (3 * hk + hh) * 64 + 32 * dd + 8 * g + 4 * h; const f32x4 gg = *(const f32x4*)(ga + col);
                const u32x2 pk = Op[hh][dd][g]; const float o0 = __uint_as_float(pk.x << 16), o1 = __uint_as_float(pk.x & 0xffff0000u), o2 = __uint_as_float(pk.y << 16), o3 = __uint_as_float(pk.y & 0xffff0000u);
                u32x2 w; w.x = pk2(o0 * rstd * gg[0], o1 * rstd * gg[1]); w.y = pk2(o2 * rstd * gg[2], o3 * rstd * gg[3]);
                *(u32x2*)(MIXED + token * D_MODEL + col) = w; }
}

DI float sb_tile(ldsp Kh, ldsp Vh, int loff, const bf16x8 (&q)[4], f32x16 (&O)[2], float R, int kt, bool diag, int qi, int h) {
    f32x16 z = zero16();
#pragma unroll
    for (int kk = 0; kk < 4; ++kk) z = mfma32(kfrag(Kh, 32 * kt + qi, kk, h), q[kk], z);
    const int lim = launder(diag ? (qi - 4 * h) : 64);
    float lb[16], v[16];
#pragma unroll
    for (int i = 0; i < 16; ++i) { const float zz = z[i], e = __expf(-fabsf(zz)), l = fminf(zz, 0.f) - __logf(1.0f + e);
        const bool strict = ((i & 3) + 8 * (i >> 2)) < lim; lb[i] = l; v[i] = strict ? (l - zz) : 0.f; }
    float t[16], G[4], P[4], off[4];
#pragma unroll
    for (int g = 0; g < 4; ++g) { t[4 * g + 3] = 0.f; t[4 * g + 2] = v[4 * g + 3]; t[4 * g + 1] = t[4 * g + 2] + v[4 * g + 2]; t[4 * g] = t[4 * g + 1] + v[4 * g + 1]; G[g] = t[4 * g] + v[4 * g]; }
#pragma unroll
    for (int g = 0; g < 4; ++g) P[g] = shx(G[g], 32);
    float run = 0.f;
#pragma unroll
    for (int g = 3; g >= 0; --g) { off[g] = h ? run : (run + P[g]); run += (G[g] + P[g]); }
#pragma unroll
    for (int i = 0; i < 16; ++i) { const bool strict = ((i & 3) + 8 * (i >> 2)) < lim;
        const float w = strict ? __expf(lb[i] + t[i] + off[i >> 2] + R) : 0.f; z[i] = w; }
#pragma unroll
    for (int s2 = 0; s2 < 2; ++s2) { const bf16x8 Pk = pack8(z, s2);
#pragma unroll
        for (int dd = 0; dd < 2; ++dd) O[dd] = mfma32(vfrag_perm_tr(Vh, loff, 32 * dd, 32 * kt + 16 * s2, h), Pk, O[dd]); }
    return R + run;
}
DI void sb_unit(ldsp lds, int u, const bf16_t* PROJ, bf16_t* MIXED, const float* gb, int tid) {
    tid = launder(tid);
    const int b = u >> 6, nb = u & 63;
    const size_t tok0 = (size_t)b * SEQ + (size_t)nb * 128;
    ldsp Ks = lds, VTs = lds + 73728; LAS int* flags = (LAS int*)(lds + 147456); LAS float* xs = (LAS float*)(lds + 147456 + 64);
    const int wave = __builtin_amdgcn_readfirstlane(tid >> 6), lane = tid & 63, p = wave & 3, hs = wave >> 2, qi = lane & 31, h = lane >> 5;
    const int loff = vt_lane_off(lane);
    bf16x8 q[2][4]; f32x16 O[2][2]; float R[2]; bool live[2];
#pragma unroll
    for (int it = 0; it < 2; ++it) { const int head = 2 * hs + it, rt = it ? 3 - p : p; const size_t token = tok0 + 32 * rt + qi;
#pragma unroll
        for (int kk = 0; kk < 4; ++kk) q[it][kk] = *(const bf16x8*)(PROJ + token * PW + C_QB + head * 64 + 16 * kk + 8 * h);
        O[it][0] = zero16(); O[it][1] = zero16(); R[it] = 0.f; live[it] = true; }
    int iter = 0;
    for (int kb = nb; kb >= 0; --kb) {
        __syncthreads();
        const size_t kt0 = (size_t)b * SEQ + (size_t)kb * 128;
        {   const int dsto[8] = {0, 18432, 36864, 55296, 73728, 73728 + 18432, 73728 + 36864, 73728 + 55296};
            const bf16_t* kp = PROJ + kt0 * PW + C_KB; const bf16_t* vp = PROJ + kt0 * PW + C_VB;
            const bf16_t* const srcs[8] = {kp, kp + 64, kp + 128, kp + 192, vp, vp + 64, vp + 128, vp + 192};
            const float lgs[8] = {0.f, 0.f, 0.f, 0.f, 0.f, 0.f, 0.f, 0.f};
            stage_tiles<8>(lds, dsto, srcs, lgs, tid); }
        __syncthreads();
#pragma unroll
        for (int it = 0; it < 2; ++it) {
            if (live[it]) { const int head = 2 * hs + it, rt = it ? 3 - p : p; ldsp Kh = Ks + head * 18432, Vh = VTs + head * 18432;
                for (int kt = (kb == nb) ? rt : 3; kt >= 0; --kt) {
                    R[it] = sb_tile(Kh, Vh, loff, q[it], O[it], R[it], kt, (kb == nb) && (kt == rt), qi, h);
                    if (__all(R[it] < SB_THR)) { live[it] = false; break; }
                }
            }
        }
        if (lane == 0) flags[(iter & 1) * 8 + wave] = (live[0] || live[1]) ? 1 : 0;
        __syncthreads();
        int any = 0;
#pragma unroll
        for (int w2 = 0; w2 < 8; ++w2) any |= flags[(iter & 1) * 8 + w2];
        ++iter;
        if (!any) break;
    }
#pragma unroll
    for (int it = 0; it < 2; ++it) { float ssq = 0.f;
#pragma unroll
        for (int dd = 0; dd < 2; ++dd)
#pragma unroll
            for (int i = 0; i < 16; ++i) ssq += O[it][dd][i] * O[it][dd][i];
        ssq += shx(ssq, 32);
        if (h == 0) xs[(2 * hs + it) * 128 + 32 * (it ? 3 - p : p) + qi] = ssq; }
    __syncthreads();
#pragma unroll
    for (int it = 0; it < 2; ++it) { const int head = 2 * hs + it, rt = it ? 3 - p : p, qrow = 32 * rt + qi; const size_t token = tok0 + qrow;
        const float rstd = rsqrtf(((xs[qrow] + xs[128 + qrow]) + (xs[256 + qrow] + xs[384 + qrow])) * (1.0f / 256.0f) + NORM_EPS);
#pragma unroll
        for (int dd = 0; dd < 2; ++dd)
#pragma unroll
            for (int g = 0; g < 4; ++g) { const int col = head * 64 + 32 * dd + 8 * g + 4 * h; const f32x4 gg = *(const f32x4*)(gb + col);
                u32x2 w; w.x = pk2(O[it][dd][4 * g] * rstd * gg[0], O[it][dd][4 * g + 1] * rstd * gg[1]); w.y = pk2(O[it][dd][4 * g + 2] * rstd * gg[2], O[it][dd][4 * g + 3] * rstd * gg[3]);
                *(u32x2*)(MIXED + token * D_MODEL + 384 + col) = w; } }
}

DI void ret_kv_load(u32x4 (&v)[4][2], int u2, const bf16_t* PROJ, int tid) {
    const int hp = u2 % 3, n = (u2 / 3) & 63, b = u2 / 192;
    const size_t tok0 = (size_t)b * SEQ + (size_t)n * 128;
    const bf16_t* kp = PROJ + tok0 * PW + C_KC + (2 * hp) * 64; const bf16_t* vp = PROJ + tok0 * PW + C_VC + (2 * hp) * 64;
    const int r0 = tid >> 3, c = tid & 7;
#pragma unroll
    for (int i = 0; i < 2; ++i) { const size_t ro = (size_t)(r0 + 64 * i) * PW + c * 8;
        v[0][i] = *(const u32x4*)(kp + ro); v[1][i] = *(const u32x4*)(kp + 64 + ro); v[2][i] = *(const u32x4*)(vp + ro); v[3][i] = *(const u32x4*)(vp + 64 + ro); }
}
DI void ret_kv_unit(ldsp lds, int u2, const u32x4 (&v)[4][2], float* KV, int tid) {
    const int hp = u2 % 3, n = (u2 / 3) & 63, b = u2 / 192;
    ldsp KTs = lds, VTs = lds + 36864;
    {   const int r0 = tid >> 3, c = tid & 7;
#pragma unroll
        for (int t = 0; t < 4; ++t)
#pragma unroll
            for (int i = 0; i < 2; ++i) { u32x4 o = v[t][i];
                if (t < 2) { const float sc = exp2f((float)(127 - (r0 + 64 * i)) * lg2gamma(2 * hp + t));
                    o.x = pk2(__uint_as_float(o.x << 16) * sc, __uint_as_float(o.x & 0xffff0000u) * sc); o.y = pk2(__uint_as_float(o.y << 16) * sc, __uint_as_float(o.y & 0xffff0000u) * sc);
                    o.z = pk2(__uint_as_float(o.z << 16) * sc, __uint_as_float(o.z & 0xffff0000u) * sc); o.w = pk2(__uint_as_float(o.w << 16) * sc, __uint_as_float(o.w & 0xffff0000u) * sc); }
                *(LAS u32x4*)(lds + t * 18432 + (r0 + 64 * i) * 144 + c * 16) = o; } }
}
DI void ret_kv_compute(ldsp lds, int u2, float* KV, int tid) {
    const int hp = u2 % 3, n = (u2 / 3) & 63, b = u2 / 192;
    ldsp KTs = lds, VTs = lds + 36864;
    const int wave = __builtin_amdgcn_readfirstlane(tid >> 6), lane = tid & 63, hs = wave >> 2, eh = (wave >> 1) & 1, dh = wave & 1, r = lane & 31, h = lane >> 5;
    const int head = 2 * hp + hs;
    f32x16 acc = zero16();
    const int loff = vt_lane_off(lane);
#pragma unroll
    for (int s = 0; s < 8; ++s) acc = mfma32(vfrag_nat_tr(VTs + hs * 18432, loff, 32 * eh, 16 * s, h), vfrag_nat_tr(KTs + hs * 18432, loff, 32 * dh, 16 * s, h), acc);
    float* base = KV + ((size_t)(b * 6 + head) * 64 + n) * 4096;
#pragma unroll
    for (int i = 0; i < 16; ++i) base[(32 * eh + crow(i, h)) * 64 + 32 * dh + r] = acc[i];
}
DI void ret_scan_phase(float* KV, int tid, int bid) {
    const int total = BATCH * 6 * 4096;
    for (int idx = bid * NTHREADS + tid; idx < total; idx += gridDim.x * NTHREADS) {
        const int bh = idx >> 12, ed = idx & 4095, head = bh % 6; const float cd = exp2f(128.0f * lg2gamma(head));
        float* p = KV + (size_t)bh * 64 * 4096 + ed; float s = 0.f;
#pragma unroll 32
        for (int n = 0; n < 64; ++n) { const float t = p[(size_t)n * 4096]; p[(size_t)n * 4096] = s; s = cd * s + t; }
    }
}
DI void ret_out_store(ldsp lds, const u32x4 (&v)[4][2], int tid) {
    const int r0 = tid >> 3, c = tid & 7;
#pragma unroll
    for (int t = 0; t < 4; ++t)
#pragma unroll
        for (int i = 0; i < 2; ++i) *(LAS u32x4*)(lds + t * 18432 + (r0 + 64 * i) * 144 + c * 16) = v[t][i];
}
DI void ret_out_unit(ldsp lds, int u2, const bf16_t* PROJ, const float* KV, bf16_t* MIXED, const float* gcn, int tid, const float* toutc) {
    const int hp = u2 % 3, n = (u2 / 3) & 63, b = u2 / 192;
    const size_t tok0 = (size_t)b * SEQ + (size_t)n * 128;
    ldsp Ks = lds, VTs = lds + 36864;
    const int wave = __builtin_amdgcn_readfirstlane(tid >> 6), lane = tid & 63, hs = wave >> 2, rt = wave & 3, qi = lane & 31, h = lane >> 5;
    const int head = 2 * hp + hs, qrow = 32 * rt + qi; const size_t token = tok0 + qrow;
    ldsp Kh = Ks + hs * 18432, Vh = VTs + hs * 18432; const int loff = vt_lane_off(lane);
    const float lg = lg2gamma(head);
    bf16x8 q[4];
#pragma unroll
    for (int kk = 0; kk < 4; ++kk) q[kk] = *(const bf16x8*)(PROJ + token * PW + C_QC + head * 64 + 16 * kk + 8 * h);
    f32x16 cross[2], intra[2];
    const float* ST = KV + ((size_t)(b * 6 + head) * 64 + n) * 4096;
#pragma unroll
    for (int eh = 0; eh < 2; ++eh) { cross[eh] = zero16(); intra[eh] = zero16();
#pragma unroll
        for (int kk = 0; kk < 4; ++kk) { const float* p = ST + (32 * eh + qi) * 64 + 16 * kk + 8 * h; const f32x4 a0 = *(const f32x4*)p, a1 = *(const f32x4*)(p + 4);
            u32x4 pa; pa.x = pk2(a0[0], a0[1]); pa.y = pk2(a0[2], a0[3]); pa.z = pk2(a1[0], a1[1]); pa.w = pk2(a1[2], a1[3]);
            cross[eh] = mfma32(__builtin_bit_cast(bf16x8, pa), q[kk], cross[eh]); } }
    for (int kt = 0; kt <= rt; ++kt) {
        f32x16 s = zero16();
#pragma unroll
        for (int kk = 0; kk < 4; ++kk) s = mfma32(kfrag(Kh, 32 * kt + qi, kk, h), q[kk], s);
        const int dbase = launder(qrow - 32 * kt - 4 * h);
#pragma unroll
        for (int i = 0; i < 16; ++i) { const int dlt = dbase - ((i & 3) + 8 * (i >> 2)); s[i] = dlt >= 0 ? s[i] * exp2f((float)dlt * lg) : 0.f; }
#pragma unroll
        for (int s2 = 0; s2 < 2; ++s2) { const bf16x8 Pk = pack8(s, s2);
#pragma unroll
            for (int dd = 0; dd < 2; ++dd) intra[dd] = mfma32(vfrag_perm_tr(Vh, loff, 32 * dd, 32 * kt + 16 * s2, h), Pk, intra[dd]); }
    }
    const float qdec = exp2f((float)(qrow + 1) * lg);
    float sum = 0.f;
#pragma unroll
    for (int dd = 0; dd < 2; ++dd)
#pragma unroll
        for (int i = 0; i < 16; ++i) { const float o = intra[dd][i] + qdec * cross[dd][i]; intra[dd][i] = o; sum += o; }
    sum += shx(sum, 32);
    const float mu = sum * (1.0f / 64.0f); float var = 0.f;
#pragma unroll
    for (int dd = 0; dd < 2; ++dd)
#pragma unroll
        for (int i = 0; i < 16; ++i) { const float d = intra[dd][i] - mu; intra[dd][i] = d; var += d * d; }
    var += shx(var, 32);
    const float rs = rsqrtf(var * (1.0f / 64.0f) + NORM_EPS);
#pragma unroll
    for (int dd = 0; dd < 2; ++dd)
#pragma unroll
        for (int g = 0; g < 4; ++g) { const int col = head * 64 + 32 * dd + 8 * g + 4 * h; const f32x4 gg = *(const f32x4*)(gcn + col);
            const u32x2 gt = *(const u32x2*)(PROJ + token * PW + C_GC + col);
            const float g0 = bf2f((unsigned short)(gt.x & 0xffffu)), g1 = bf2f((unsigned short)(gt.x >> 16)), g2 = bf2f((unsigned short)(gt.y & 0xffffu)), g3 = bf2f((unsigned short)(gt.y >> 16));
            const float o0 = intra[dd][4 * g] * rs * gg[0] * (g0 / (1.0f + __expf(-g0))), o1 = intra[dd][4 * g + 1] * rs * gg[1] * (g1 / (1.0f + __expf(-g1)));
            const float o2 = intra[dd][4 * g + 2] * rs * gg[2] * (g2 / (1.0f + __expf(-g2))), o3 = intra[dd][4 * g + 3] * rs * gg[3] * (g3 / (1.0f + __expf(-g3)));
            u32x2 w; w.x = pk2(o0, o1); w.y = pk2(o2, o3);
            if (n == 0 && qrow == 0) { const f32x4 ex = *(const f32x4*)(toutc + b * 384 + col); w.x = pk2(ex[0], ex[1]); w.y = pk2(ex[2], ex[3]); }
            *(u32x2*)(MIXED + token * D_MODEL + 640 + col) = w; }
}

constexpr size_t WS_T0 = 103 * MiB;
constexpr int T0_XM = 16384, T0_PROJ = 24576, T0_Y1 = 49152, T0_Y2 = 57344, T0_HT = 65536, T0_OUTC = 98304;
template <int KN> DI float t0_gemv16(const float* W, int N, int n0, const float* inT, ldsp redb, int tid) {
    const int cl = tid & 3, ks = tid >> 2;
    float acc[8][4];
#pragma unroll
    for (int r = 0; r < 8; ++r)
#pragma unroll
        for (int c = 0; c < 4; ++c) acc[r][c] = 0.f;
    const float* wp = W + (size_t)(ks * KN) * N + n0 + 4 * cl; const float* ip = inT + (size_t)(ks * KN) * 8;
#pragma unroll
    for (int k0 = 0; k0 < KN; k0 += 8) {
        f32x4 w[8];
#pragma unroll
        for (int k = 0; k < 8; ++k) w[k] = *(const f32x4*)(wp + (size_t)(k0 + k) * N);
#pragma unroll
        for (int k = 0; k < 8; ++k) { const f32x4 i0 = *(const f32x4*)(ip + (k0 + k) * 8), i1 = *(const f32x4*)(ip + (k0 + k) * 8 + 4);
#pragma unroll
            for (int r = 0; r < 4; ++r)
#pragma unroll
                for (int c = 0; c < 4; ++c) { acc[r][c] += i0[r] * w[k][c]; acc[4 + r][c] += i1[r] * w[k][c]; } } }
    LAS float* red = (LAS float*)redb;
#pragma unroll
    for (int r = 0; r < 8; ++r) *(LAS f32x4*)(red + (ks * 4 + cl) * 32 + r * 4) = (f32x4){acc[r][0], acc[r][1], acc[r][2], acc[r][3]};
    __syncthreads();
    float s = 0.f;
    if (tid < 128) { const int r = tid >> 4, c = tid & 15;
#pragma unroll 16
        for (int j = 0; j < 128; ++j) s += red[(j * 4 + (c >> 2)) * 32 + r * 4 + (c & 3)]; }
    __syncthreads();
    return s;
}
DI void t0_load_row(const float* p, int lane, f32x4 (&x)[4]) {
#pragma unroll
    for (int j = 0; j < 4; ++j) x[j] = *((const f32x4*)p + lane + 64 * j); }
DI float t0_ssq(const f32x4 (&x)[4]) { float s = 0.f;
#pragma unroll
    for (int j = 0; j < 4; ++j) s += (x[j][0] * x[j][0] + x[j][1] * x[j][1]) + (x[j][2] * x[j][2] + x[j][3] * x[j][3]);
    return wave_sum(s); }
DI void t0_put_inT(LAS float* inT, const f32x4 (&x)[4], const float* g, int lane, int r) {
#pragma unroll
    for (int j = 0; j < 4; ++j) { const f32x4 gg = *((const f32x4*)g + lane + 64 * j);
#pragma unroll
        for (int e = 0; e < 4; ++e) inT[(lane * 4 + 256 * j + e) * 8 + r] = x[j][e] * gg[e]; } }
DI void t0_store_row(float* p, int lane, const f32x4 (&x)[4]) {
#pragma unroll
    for (int j = 0; j < 4; ++j) *((f32x4*)p + lane + 64 * j) = x[j]; }
DI void t0_stage1(unsigned char* ldsg, unsigned char* ws, int l, int tb, const float* xin, const float* w_in_l, const float* g_post_prev, const float* g_pre, int tid) {
    tid = launder(tid);
    float* T = (float*)(ws + WS_T0); const int r = tid >> 6, lane = tid & 63;
    LAS float* inT = (LAS float*)(ldsp)ldsg; LAS float* rs = (LAS float*)((ldsp)ldsg + 98304);
    f32x4 x[4];
    if (l == 0) t0_load_row(xin + (size_t)r * SEQ * D_MODEL, lane, x);
    else { f32x4 y[4]; t0_load_row(T + T0_XM + r * 1024, lane, x); t0_load_row(T + T0_Y2 + r * 1024, lane, y);
        const float rstd = rsqrtf(t0_ssq(y) * (1.0f / D_MODEL) + NORM_EPS);
#pragma unroll
        for (int j = 0; j < 4; ++j) x[j] = x[j] + y[j] * rstd * *((const f32x4*)g_post_prev + lane + 64 * j); }
    const float rstdx = rsqrtf(t0_ssq(x) * (1.0f / D_MODEL) + NORM_EPS);
    if (lane == 0) rs[r] = rstdx;
    t0_put_inT(inT, x, g_pre, lane, r);
    if (tb == 0) t0_store_row(T + (l & 1) * 8192 + r * 1024, lane, x);
    __syncthreads();
    const float s = t0_gemv16<8>(w_in_l, IN_W, 16 * tb, (const float*)ldsg, (ldsp)ldsg + 32768, tid);
    if (tid < 128) T[T0_PROJ + (tid >> 4) * 3072 + 16 * tb + (tid & 15)] = s * rs[tid >> 4];
    __syncthreads();
}
DI void t0_stage2(unsigned char* ldsg, unsigned char* ws, int l, int tb, const float* w_out_l, const float* sinks_l, const float* bg, const float* rope_c, const float* rope_s, int tid) {
    tid = launder(tid);
    float* T = (float*)(ws + WS_T0); const int r = tid >> 6, lane = tid & 63;
    LAS float* inT = (LAS float*)(ldsp)ldsg; const float* P = T + T0_PROJ + r * 3072;
    const float cc = rope_c[lane & 31], ss = rope_s[lane & 31];
#define T0_ROPE(v, dst) { const float v_ = (v), o_ = shx(v_, 32); dst = (lane < 32) ? (v_ * cc - o_ * ss) : (o_ * ss + v_ * cc); }
    float outa[6]; float ssqA = 0.f;
#pragma unroll
    for (int kv = 0; kv < 2; ++kv) { float ka; T0_ROPE(P[C_KA + kv * 64 + lane], ka); const float va = P[C_VA + kv * 64 + lane];
#pragma unroll
        for (int g = 0; g < 3; ++g) { const int h = 3 * kv + g; float qa; T0_ROPE(P[C_QA + h * 64 + lane], qa);
            const float sc = wave_sum(qa * ka) * 0.125f, sink = sinks_l[h], mx = fmaxf(sc, sink), e1 = expf(sc - mx), e2 = expf(sink - mx);
            outa[h] = (e1 / (e1 + e2)) * va; ssqA += outa[h] * outa[h]; } }
    const float rstdA = rsqrtf(wave_sum(ssqA) * (1.0f / 384.0f) + NORM_EPS);
#pragma unroll
    for (int h = 0; h < 6; ++h) inT[(h * 64 + lane) * 8 + r] = outa[h] * rstdA * bg[h * 64 + lane];
#pragma unroll
    for (int h = 0; h < 4; ++h) inT[(384 + h * 64 + lane) * 8 + r] = 0.f;
#pragma unroll
    for (int h = 0; h < 6; ++h) { float qc, kc; T0_ROPE(P[C_QC + h * 64 + lane], qc); T0_ROPE(P[C_KC + h * 64 + lane], kc);
        const float c = wave_sum(qc * kc) * 0.125f, o = c * P[C_VC + h * 64 + lane], mu = wave_sum(o) * (1.0f / 64.0f), d = o - mu, var = wave_sum(d * d) * (1.0f / 64.0f);
        const float gt = P[C_GC + h * 64 + lane], oc = d * rsqrtf(var + NORM_EPS) * bg[640 + h * 64 + lane] * (gt / (1.0f + expf(-gt)));
        inT[(640 + h * 64 + lane) * 8 + r] = oc;
        if (tb == 0) T[T0_OUTC + r * 384 + h * 64 + lane] = oc; }
#undef T0_ROPE
    __syncthreads();
    const float s = t0_gemv16<8>(w_out_l, D_MODEL, 16 * tb, (const float*)ldsg, (ldsp)ldsg + 32768, tid);
    if (tid < 128) T[T0_Y1 + (tid >> 4) * 1024 + 16 * tb + (tid & 15)] = s;
    __syncthreads();
}
DI void t0_stage3(unsigned char* ldsg, unsigned char* ws, int l, int tb, const float* w_up_l, const float* g_post, const float* g_pre, int tid) {
    tid = launder(tid);
    float* T = (float*)(ws + WS_T0); const int r = tid >> 6, lane = tid & 63;
    LAS float* inT = (LAS float*)(ldsp)ldsg; LAS float* rs = (LAS float*)((ldsp)ldsg + 98304);
    f32x4 x[4], y[4]; t0_load_row(T + (l & 1) * 8192 + r * 1024, lane, x); t0_load_row(T + T0_Y1 + r * 1024, lane, y);
    const float rstd = rsqrtf(t0_ssq(y) * (1.0f / D_MODEL) + NORM_EPS);
#pragma unroll
    for (int j = 0; j < 4; ++j) x[j] = x[j] + y[j] * rstd * *((const f32x4*)g_post + lane + 64 * j);
    const float rstdx = rsqrtf(t0_ssq(x) * (1.0f / D_MODEL) + NORM_EPS);
    if (lane == 0) rs[r] = rstdx;
    t0_put_inT(inT, x, g_pre, lane, r);
    if (tb == 0) t0_store_row(T + T0_XM + r * 1024, lane, x);
    __syncthreads();
    const float s = t0_gemv16<8>(w_up_l, D_FF, 16 * tb, (const float*)ldsg, (ldsp)ldsg + 32768, tid);
    if (tid < 128) { const float v = fmaxf(s * rs[tid >> 4], 0.f); T[T0_HT + (16 * tb + (tid & 15)) * 8 + (tid >> 4)] = v * v; }
    __syncthreads();
}
DI void t0_stage4(unsigned char* ldsg, unsigned char* ws, int tb, const float* w_down_l, int tid) {
    tid = launder(tid);
    float* T = (float*)(ws + WS_T0);
    const float s = t0_gemv16<32>(w_down_l, D_MODEL, 16 * tb, T + T0_HT, (ldsp)ldsg + 32768, tid);
    if (tid < 128) T[T0_Y2 + (tid >> 4) * 1024 + 16 * tb + (tid & 15)] = s;
    __syncthreads();
}

DI f32x4 unpk4(u32x2 w) { f32x4 r; r[0] = __uint_as_float(w.x << 16); r[1] = __uint_as_float(w.x & 0xffff0000u); r[2] = __uint_as_float(w.y << 16); r[3] = __uint_as_float(w.y & 0xffff0000u); return r; }
template <bool SRC_BF, bool DST_BF>
DI void norm_res_phase(const void* xsrc_, const bf16_t* Y, const float* gpost, const float* gpre, void* xout_, bf16_t* XN, int tid, int bid) {
    constexpr int NR = 4;
    const int wave = tid >> 6, lane = tid & 63, NW = gridDim.x * NWAVES;
    for (int row0 = bid * NWAVES + wave; row0 < M_TOK; row0 += NR * NW) {
        f32x4 xf[SRC_BF ? 1 : NR][4]; u32x2 xraw[SRC_BF ? NR : 1][4]; u32x2 yraw[NR][4];
#pragma unroll
        for (int r = 0; r < NR; ++r) { const size_t row = (size_t)row0 + (size_t)r * NW;
            if (SRC_BF) { const u32x2* xr = (const u32x2*)((const bf16_t*)xsrc_ + row * D_MODEL) + lane;
#pragma unroll
                for (int j = 0; j < 4; ++j) xraw[SRC_BF ? r : 0][j] = xr[64 * j];
            } else { const f32x4* xr = (const f32x4*)((const float*)xsrc_ + row * D_MODEL) + lane;
#pragma unroll
                for (int j = 0; j < 4; ++j) xf[SRC_BF ? 0 : r][j] = xr[64 * j]; }
            if (Y) { const u32x2* yr = (const u32x2*)(Y + row * D_MODEL) + lane;
#pragma unroll
                for (int j = 0; j < 4; ++j) yraw[r][j] = yr[64 * j]; } }
        f32x4 gp[4], gq[4];
        if (Y) {
#pragma unroll
            for (int j = 0; j < 4; ++j) gp[j] = *((const f32x4*)gpost + lane + 64 * j); }
        if (XN) {
#pragma unroll
            for (int j = 0; j < 4; ++j) gq[j] = *((const f32x4*)gpre + lane + 64 * j); }
#pragma unroll
        for (int r = 0; r < NR; ++r) { const size_t row = (size_t)row0 + (size_t)r * NW;
            f32x4 v[4];
#pragma unroll
            for (int j = 0; j < 4; ++j) v[j] = SRC_BF ? unpk4(xraw[SRC_BF ? r : 0][j]) : xf[SRC_BF ? 0 : r][j];
            if (Y) { f32x4 y[4]; float s = 0.f;
#pragma unroll
                for (int j = 0; j < 4; ++j) { y[j] = unpk4(yraw[r][j]); s += (y[j][0] * y[j][0] + y[j][1] * y[j][1]) + (y[j][2] * y[j][2] + y[j][3] * y[j][3]); }
                const float rstd = rsqrtf(wave_sum(s) * (1.0f / D_MODEL) + NORM_EPS);
#pragma unroll
                for (int j = 0; j < 4; ++j) v[j] = v[j] + y[j] * rstd * gp[j]; }
            if (xout_) {
                if (DST_BF) { u32x2* xo = (u32x2*)((bf16_t*)xout_ + row * D_MODEL) + lane;
#pragma unroll
                    for (int j = 0; j < 4; ++j) { u32x2 w; w.x = pk2(v[j][0], v[j][1]); w.y = pk2(v[j][2], v[j][3]); xo[64 * j] = w;
                        v[j] = unpk4(w); }
                } else { f32x4* xo = (f32x4*)((float*)xout_ + row * D_MODEL) + lane;
#pragma unroll
                    for (int j = 0; j < 4; ++j) xo[64 * j] = v[j]; } }
            if (XN) { float s = 0.f;
#pragma unroll
                for (int j = 0; j < 4; ++j) s += (v[j][0] * v[j][0] + v[j][1] * v[j][1]) + (v[j][2] * v[j][2] + v[j][3] * v[j][3]);
                const float rstd = rsqrtf(wave_sum(s) * (1.0f / D_MODEL) + NORM_EPS);
                u32x2* xo = (u32x2*)(XN + row * D_MODEL) + lane;
#pragma unroll
                for (int j = 0; j < 4; ++j) { const f32x4 o = v[j] * rstd * gq[j]; u32x2 w; w.x = pk2(o[0], o[1]); w.y = pk2(o[2], o[3]); xo[64 * j] = w; } }
        }
    }
}
template <int MODE> DI void transpose_item(const float* W, int K, int Nsrc, int Ndst, bf16_t* WT, LAS float* scr, int item, int lane, const float* gk) {
    const int nblk = Ndst / 32, kb = item / nblk, nbk = item % nblk, k0 = 64 * kb, n0 = 32 * nbk;
    const int nd = n0 + (lane & 31); int src = nd; float sc = 1.f; bool ok = true;
    if (MODE == 1) { const int head = nd >> 6, p = nd & 63; const bool rope = (head < 8) || (head >= 22 && head < 34);
        const int f = rope ? (4 * (p >> 3) + (p & 3) + 32 * ((p >> 2) & 1)) : p; ok = nd < IN_W; src = ok ? head * 64 + f : 0;
        sc = ((head < 6) || (head >= 10 && head < 14) || (head >= 28 && head < 34)) ? 0.125f : 1.f; }
#pragma unroll
    for (int i = 0; i < 32; ++i) { const int kk = 2 * i + (lane >> 5); scr[kk * 33 + (lane & 31)] = ok ? W[(size_t)(k0 + kk) * Nsrc + src] * (gk ? sc * gk[k0 + kk] : sc) : 0.f; }
    LDS_WAIT();
    const int c = lane & 7;
#pragma unroll
    for (int j = 0; j < 4; ++j) { const int n = (lane >> 3) + 8 * j; const LAS float* s = scr + (8 * c) * 33 + n;
        u32x4 o; o.x = pk2(s[0 * 33], s[1 * 33]); o.y = pk2(s[2 * 33], s[3 * 33]); o.z = pk2(s[4 * 33], s[5 * 33]); o.w = pk2(s[6 * 33], s[7 * 33]);
        *(u32x4*)(WT + (size_t)(n0 + n) * K + k0 + 8 * c) = o; }
    LDS_WAIT();
}

#ifdef DUP_MIX
#define MIXREP 2
#else
#define MIXREP 1
#endif
#ifdef DUP_P2
#define MIXREP2 2
#else
#define MIXREP2 MIXREP
#endif
struct Args { const float* x; const int* positions; const float* w_in; const float* w_out; const float* sinks; const float* branch_gain; const float* w_up; const float* w_down;
              const float* g_mix_pre; const float* g_mix_post; const float* g_mlp_pre; const float* g_mlp_post; float* out; unsigned char* ws; int ph_lo, ph_hi; };

__global__ void __launch_bounds__(NTHREADS, 2) fwd_kernel(Args a) {
    extern __shared__ __attribute__((aligned(16))) unsigned char lds_raw[];
    ldsp lds = (ldsp)lds_raw;
    cg::grid_group grid = cg::this_grid();
    const int G = gridDim.x;
    unsigned char* ws = a.ws;
    float* ROPE_C = (float*)(ws + WS_ROPE); float* ROPE_S = ROPE_C + SEQ * 32;
    bf16_t* XN = (bf16_t*)(ws + WS_XN); bf16_t* Y = (bf16_t*)(ws + WS_Y); bf16_t* PROJ = (bf16_t*)(ws + WS_PROJ); bf16_t* MIXED = (bf16_t*)(ws + WS_MIXED); bf16_t* H = (bf16_t*)(ws + WS_H); bf16_t* XB = (bf16_t*)(ws + WS_XB); float* PS1 = (float*)(ws + WS_PS1); float* PS2 = (float*)(ws + WS_PS2); unsigned* CNT = (unsigned*)(ws + WS_CNT);
    float* KV = (float*)(ws + WS_KV);
    volatile LAS unsigned* MISC = (volatile LAS unsigned*)(lds + 155392);
    if (threadIdx.x < 16) MISC[threadIdx.x] = 0u;
    __syncthreads();
    const XcdBarrier xbar = xcd_barrier_post((unsigned*)ws + 4096, MISC + 8);
    const int lo = a.ph_lo, hi = a.ph_hi;
    for (int ph = lo; ph < hi; ++ph) {
        int tid_l = threadIdx.x, bid_l = blockIdx.x; asm volatile("" : "+v"(tid_l)); asm volatile("" : "+s"(bid_l));
        const int tid = tid_l, bid = bid_l, wave = __builtin_amdgcn_readfirstlane(tid >> 6), lane = tid & 63;
        if (ph == 0) {
#ifdef DUP_P0
            for (int rep0_ = 0; rep0_ < 2; ++rep0_) {
#endif
            for (int idx = bid * NTHREADS + tid; idx < SEQ * 32; idx += G * NTHREADS) { const int s = idx >> 5, i = idx & 31;
                const float inv = powf(10000.0f, -(float)(2 * i) / 64.0f), ang = (float)a.positions[s] * inv; ROPE_C[idx] = cosf(ang); ROPE_S[idx] = sinf(ang); }
            LAS float* scr = (LAS float*)(lds + wave * 16384);
            constexpr int I_IN = 16 * 96, I_OUT = 16 * 32, I_UP = 16 * 128, I_DN = 64 * 32, I_L = I_IN + I_OUT + I_UP + I_DN;
            for (int it = bid * NWAVES + wave; it < DEPTH * I_L; it += G * NWAVES) {
                const int l = it / I_L; int r = it % I_L; unsigned char* wl = ws + WS_W + (size_t)l * W_LAYER;
                if (r < I_IN) { transpose_item<1>(a.w_in + (size_t)l * D_MODEL * IN_W, D_MODEL, IN_W, PW, (bf16_t*)wl, scr, r, lane, a.g_mix_pre + l * D_MODEL); continue; } r -= I_IN;
                if (r < I_OUT) { transpose_item<0>(a.w_out + (size_t)l * D_MODEL * D_MODEL, D_MODEL, D_MODEL, D_MODEL, (bf16_t*)(wl + W_OUT_OFF), scr, r, lane, nullptr); continue; } r -= I_OUT;
                if (r < I_UP) { transpose_item<0>(a.w_up + (size_t)l * D_MODEL * D_FF, D_MODEL, D_FF, D_FF, (bf16_t*)(wl + W_UP_OFF), scr, r, lane, a.g_mlp_pre + l * D_MODEL); continue; } r -= I_UP;
                transpose_item<0>(a.w_down + (size_t)l * D_FF * D_MODEL, D_FF, D_MODEL, D_MODEL, (bf16_t*)(wl + W_DOWN_OFF), scr, r, lane, nullptr);
            }
            for (int idx = bid * NTHREADS + tid; idx < DEPTH * 4 * D_MODEL; idx += G * NTHREADS) { const int l = idx >> 12, w = (idx >> 10) & 3, c = idx & 1023;
                const float* srcg = (w == 0) ? a.g_mix_pre : (w == 1) ? a.g_mix_post : (w == 2) ? a.g_mlp_pre : a.g_mlp_post; ((float*)(ws + WS_GAIN))[idx] = srcg[l * D_MODEL + c]; }
            for (int row0 = bid * NWAVES + wave; row0 < M_TOK; row0 += 4 * G * NWAVES) {
                f32x4 v[4][4];
#pragma unroll
                for (int r = 0; r < 4; ++r) { const f32x4* xr = (const f32x4*)(a.x + ((size_t)row0 + (size_t)r * G * NWAVES) * D_MODEL) + lane;
#pragma unroll
                    for (int j = 0; j < 4; ++j) v[r][j] = xr[64 * j]; }
#pragma unroll
                for (int r = 0; r < 4; ++r) { const size_t row = (size_t)row0 + (size_t)r * G * NWAVES; float s = 0.f;
#pragma unroll
                    for (int j = 0; j < 4; ++j) s += (v[r][j][0] * v[r][j][0] + v[r][j][1] * v[r][j][1]) + (v[r][j][2] * v[r][j][2] + v[r][j][3] * v[r][j][3]);
#pragma unroll
                    for (int j = 0; j < 4; ++j) { u32x2 wb; wb.x = pk2(v[r][j][0], v[r][j][1]); wb.y = pk2(v[r][j][2], v[r][j][3]); ((u32x2*)(XB + row * D_MODEL) + lane)[64 * j] = wb; }
                    s = wave_sum(s);
                    if (lane == 0) *(f32x4*)(PS2 + row * 4) = (f32x4){s, 0.f, 0.f, 0.f}; }
            }
            __syncthreads();
#ifdef DUP_P0
            }
#endif
        } else {
            const int l = (ph - 1) / 7, k = (ph - 1) % 7;
            unsigned char* wl = ws + WS_W + (size_t)l * W_LAYER;
            const float* bg = a.branch_gain + l * D_MODEL;
            if (k == 0 && bid < 184) t0_stage1(lds_raw, ws, l, bid, a.x, a.w_in + (size_t)l * D_MODEL * IN_W, a.g_mlp_post + (l > 0 ? l - 1 : 0) * D_MODEL, a.g_mix_pre + l * D_MODEL, tid);
            if (k == 1 && bid >= 192) t0_stage2(lds_raw, ws, l, bid - 192, a.w_out + (size_t)l * D_MODEL * D_MODEL, a.sinks + l * 6, bg, ROPE_C, ROPE_S, tid);
            if (k == 2) t0_stage3(lds_raw, ws, l, bid, a.w_up + (size_t)l * D_MODEL * D_FF, a.g_mix_post + l * D_MODEL, a.g_mlp_pre + l * D_MODEL, tid);
            if (k == 3 && bid < 64) t0_stage4(lds_raw, ws, bid, a.w_down + (size_t)l * D_FF * D_MODEL, tid);
            if (k == 0 || k >= 4) {
                const bf16_t* A = XB; const bf16_t* Bt = (const bf16_t*)wl; int N = PW, K = D_MODEL;
                int mode = 2;
                if (k == 4) { A = MIXED; Bt = (const bf16_t*)(wl + W_OUT_OFF); N = D_MODEL; mode = 3; }
                if (k == 5) { Bt = (const bf16_t*)(wl + W_UP_OFF); N = D_FF; mode = 1; }
                if (k == 6) { A = H; Bt = (const bf16_t*)(wl + W_DOWN_OFF); N = D_MODEL; K = D_FF; mode = 4; }
                pg8::EpiAny E{ws, a.x, a.out, mode, l};
                pg8::Gemm g{A, Bt, M_TOK, N, K}; pg8::StaticOrder S; S.init(M_TOK, N, G, bid);
                pg8::gemm_phase<pg8::EpiAny, pg8::StaticOrder, PG8_ALIGN, PG8_SP2>(lds, g, S, E, tid);
            } else if (k == 1) {
                int u_ = (G == 256) ? ((bid & 7) * 32 + (bid >> 3)) : bid;
                for (; u_ < 512; u_ += G) swa_unit(lds, u_, PROJ, MIXED, a.sinks + l * 6, bg, tid);
                {
                    const int tl = launder(tid);
                    u32x4 pre[4][2];
#pragma unroll
                    for (int t_ = 0; t_ < 4; ++t_) { pre[t_][0] = (u32x4){0u, 0u, 0u, 0u}; pre[t_][1] = (u32x4){0u, 0u, 0u, 0u}; }
                    if (u_ < 2048) ret_kv_load(pre, u_ - 512, PROJ, tl);
                    for (; u_ < 2048; u_ += G) {
                        __syncthreads();
                        ret_kv_unit(lds, u_ - 512, pre, KV, tl);
                        __syncthreads();
                        if (u_ + G < 2048) ret_kv_load(pre, u_ + G - 512, PROJ, tl);
                        ret_kv_compute(lds, u_ - 512, KV, tl);
                    }
                }
                __syncthreads();
            } else if (k == 2) {
                ret_scan_phase(KV, tid, bid);
            } else {
                int u_ = (G == 256) ? ((bid & 7) * 32 + (bid >> 3)) : bid;
                for (; u_ < 512; u_ += G) sb_unit(lds, u_, PROJ, MIXED, bg + 384, tid);
                {
                    const int tl = launder(tid);
                    u32x4 pre[4][2];
#pragma unroll
                    for (int t_ = 0; t_ < 4; ++t_) { pre[t_][0] = (u32x4){0u, 0u, 0u, 0u}; pre[t_][1] = (u32x4){0u, 0u, 0u, 0u}; }
                    if (u_ < 2048) ret_kv_load(pre, u_ - 512, PROJ, tl);
                    for (; u_ < 2048; u_ += G) {
                        __syncthreads();
                        ret_out_store(lds, pre, tl);
                        __syncthreads();
                        if (u_ + G < 2048) ret_kv_load(pre, u_ + G - 512, PROJ, tl);
                        ret_out_unit(lds, u_ - 512, PROJ, KV, MIXED, bg + 640, tl, (const float*)(ws + WS_T0) + T0_OUTC);
                    }
                }
                __syncthreads();
            }
        }
        if (ph + 1 < hi) { if (ph == lo) grid.sync(); else xcd_barrier(xbar); }
    }
}

extern "C" void kernel_launch(void* const* d_in, const int* in_sizes, int n_in, void* d_out, int out_size, void* d_ws, size_t ws_size, hipStream_t stream) {
    static int grid = 0;
    if (grid == 0) {
        if (n_in != 12 || in_sizes[0] != M_TOK * D_MODEL || out_size != M_TOK * D_MODEL || ws_size < WS_END) { fprintf(stderr, "kernel_launch: unexpected shapes (n_in %d in0 %d out %d ws %zu)\n", n_in, n_in > 0 ? in_sizes[0] : -1, out_size, ws_size); grid = -1; return; }
        int dev = 0, cus = 0, per_cu = 0;
        if (hipGetDevice(&dev) != hipSuccess || hipDeviceGetAttribute(&cus, hipDeviceAttributeMultiprocessorCount, dev) != hipSuccess) { grid = -1; return; }
        if (hipFuncSetAttribute((const void*)fwd_kernel, hipFuncAttributeMaxDynamicSharedMemorySize, LDS_BYTES) != hipSuccess) { fprintf(stderr, "kernel_launch: hipFuncSetAttribute failed\n"); grid = -1; return; }
        if (hipOccupancyMaxActiveBlocksPerMultiprocessor(&per_cu, (const void*)fwd_kernel, NTHREADS, LDS_BYTES) != hipSuccess || per_cu < 1) fprintf(stderr, "kernel_launch: occupancy query reports %d\n", per_cu);
        (void)hipGetLastError();
        grid = cus;
    }
    if (grid < 0) return;
    if (hipMemsetAsync(d_ws, 0, 262144, stream) != hipSuccess) { fprintf(stderr, "kernel_launch: memset of the barrier words failed\n"); return; }
    Args a{};
    a.x = (const float*)d_in[0]; a.positions = (const int*)d_in[1]; a.w_in = (const float*)d_in[2]; a.w_out = (const float*)d_in[3]; a.sinks = (const float*)d_in[4]; a.branch_gain = (const float*)d_in[5];
    a.w_up = (const float*)d_in[6]; a.w_down = (const float*)d_in[7]; a.g_mix_pre = (const float*)d_in[8]; a.g_mix_post = (const float*)d_in[9]; a.g_mlp_pre = (const float*)d_in[10]; a.g_mlp_post = (const float*)d_in[11];
    a.out = (float*)d_out; a.ws = (unsigned char*)d_ws; a.ph_lo = 0; a.ph_hi = 1 + 7 * DEPTH;
    void* args[] = {&a};
    hipError_t e = hipLaunchCooperativeKernel((const void*)fwd_kernel, dim3(grid), dim3(NTHREADS), args, LDS_BYTES, stream);
    if (e != hipSuccess) fprintf(stderr, "kernel_launch: cooperative launch failed: %s (grid %d)\n", hipGetErrorString(e), grid);
}
```

```cpp
#include <hip/hip_runtime.h>
#include <hip/hip_cooperative_groups.h>
#include <cstdio>
#include <cstdint>
namespace cg = cooperative_groups;
#define PG8_SP2 true
#define PG8_ALIGN true
constexpr int D_MODEL = 1024, BATCH = 8, SEQ = 8192, DEPTH = 4, M_TOK = BATCH * SEQ, D_FF = 4096;
constexpr int IN_W = 2944, PW = 3072;
constexpr int C_QA = 0, C_KA = 384, C_VA = 512, C_QB = 640, C_KB = 896, C_VB = 1152, C_QC = 1408, C_KC = 1792, C_VC = 2176, C_GC = 2560;
constexpr float NORM_EPS = 1e-6f;
constexpr float SB_THR = -36.0f;
constexpr int NWAVES = 8, NTHREADS = 512;
constexpr int LDS_BYTES = 155648;
constexpr size_t MiB = 1u << 20;
constexpr size_t WS_ROPE = 1 * MiB;
constexpr size_t WS_W = 4 * MiB;
constexpr size_t W_LAYER = 24 * MiB, W_OUT_OFF = 6 * MiB, W_UP_OFF = 8 * MiB, W_DOWN_OFF = 16 * MiB;
constexpr size_t WS_CNT = 65536;
constexpr size_t WS_PS1 = 100 * MiB;
constexpr size_t WS_PS2 = 101 * MiB;
constexpr size_t WS_GAIN = 102 * MiB;
constexpr size_t WS_XN = 104 * MiB;
constexpr size_t WS_MIXED = 232 * MiB;
constexpr size_t WS_Y = 232 * MiB;
constexpr size_t WS_H = 360 * MiB;
constexpr size_t WS_PROJ = 360 * MiB;
constexpr size_t WS_KV = 744 * MiB;
constexpr size_t WS_XB = 872 * MiB;
constexpr size_t WS_END = 1000 * MiB;

__device__ __forceinline__ float shx(float v, int msk) { int l = __builtin_amdgcn_mbcnt_hi(~0u, __builtin_amdgcn_mbcnt_lo(~0u, 0u)); asm volatile("" : "+v"(l)); return __int_as_float(__builtin_amdgcn_ds_bpermute((l ^ msk) << 2, __float_as_int(v))); }
namespace pg8 {
#define PG8_LAS __attribute__((address_space(3)))
typedef unsigned short bf16_t;
typedef short bf16x8 __attribute__((ext_vector_type(8)));
typedef float f32x4 __attribute__((ext_vector_type(4)));
typedef unsigned u32x4 __attribute__((ext_vector_type(4)));
constexpr int BM = 256, BK = 64, HALF = 128, HTB = HALF * BK * 2  , STAGE_BYTES = 8 * HTB, NXCD = 8, WGM = 8;

__host__ __device__ __forceinline__ int lds_byte(int r, int c) { const int st = (r >> 4) * 2 + (c >> 5), rr = r & 15, cc = c & 31, ob = rr * 64 + cc * 2; return st * 1024 + (ob ^ (((ob >> 9) & 1) << 5)); }
__host__ __device__ __forceinline__ void stage_rc(int b, int& R, int& C) { const int st = b / 1024, sb = b % 1024, swz = sb ^ (((sb >> 9) & 1) << 5); R = (st >> 1) * 16 + swz / 64; C = (st & 1) * 32 + (swz % 64) / 2; }
__host__ __device__ __forceinline__ int perm32(int rho) { const int n = rho >> 4, i = rho & 15; return 8 * (i >> 2) + 4 * n + (i & 3); }

struct Unit { int pm, pn; };
struct Gemm { const bf16_t* A; const bf16_t* Bt; int M, N, K; };

struct StaticOrder {
    int nM, nN, nwg, G, c;
    __host__ __device__ void init(int M, int N, int G_, int c_) { nM = M / BM; nN = N / BM; nwg = nM * nN; G = G_; c = c_; }
    __host__ __device__ bool next(int i, Unit& u) const {
        const long L = (long)i * G + c; if (L >= nwg) return false;
        int wgid = (int)L; { const int q = nwg / NXCD, r = nwg % NXCD, xcd = wgid % NXCD, off = wgid / NXCD; wgid = (xcd < r ? xcd * (q + 1) : r * (q + 1) + (xcd - r) * q) + off; }
        const int nig = WGM * nN, gid = wgid / nig, fm = gid * WGM, gsz = (nM - fm) < WGM ? (nM - fm) : WGM;
        u.pm = fm + ((wgid % nig) % gsz); u.pn = (wgid % nig) / gsz; return true;
    }
    __device__ __forceinline__ void a_ready(const Unit&) const {}
    __device__ __forceinline__ void done(const Unit&) const {}
};
typedef __bf16 bf16v2_t __attribute__((ext_vector_type(2)));
typedef float f32v2_t __attribute__((ext_vector_type(2)));
typedef unsigned u32x2 __attribute__((ext_vector_type(2)));
__device__ __forceinline__ unsigned pk2(float lo, float hi) { f32v2_t v = {lo, hi}; bf16v2_t b = __builtin_convertvector(v, bf16v2_t); return __builtin_bit_cast(unsigned, b); }
template <int ACT> struct EpiPlain {
    static constexpr bool PERM = true, AFTER_DRAIN = false;
    bf16_t* O; int ldc;
    __device__ __forceinline__ void operator()(const f32x4 (&acc)[2][2][4][2], const Unit& u, int wr, int wc, int fr, int fq) const {
        const int row0 = u.pm * BM + wr * 64 + fr, col0 = u.pn * BM + wc * 32 + 8 * fq;
#pragma unroll
        for (int ai = 0; ai < 2; ++ai)
#pragma unroll
            for (int m = 0; m < 4; ++m) { bf16_t* rowp = O + (size_t)(row0 + ai * HALF + m * 16) * ldc + col0;
#pragma unroll
                for (int bj = 0; bj < 2; ++bj) { f32x4 v0 = acc[ai][bj][m][0], v1 = acc[ai][bj][m][1];
                    if (ACT == 1) {
#pragma unroll
                        for (int j = 0; j < 4; ++j) { const float a = fmaxf(v0[j], 0.f), b = fmaxf(v1[j], 0.f); v0[j] = a * a; v1[j] = b * b; } }
                    u32x4 w; w.x = pk2(v0[0], v0[1]); w.y = pk2(v0[2], v0[3]); w.z = pk2(v1[0], v1[1]); w.w = pk2(v1[2], v1[3]);
                    *(u32x4*)(rowp + bj * HALF) = w; } }
    }
};
struct EpiRope {
    static constexpr bool PERM = true, AFTER_DRAIN = false;
    bf16_t* O; int ldc; const float* cs; const float* sn; int seq_mask;
    __device__ __forceinline__ void operator()(const f32x4 (&acc)[2][2][4][2], const Unit& u, int wr, int wc, int fr, int fq) const {
        const int row0 = u.pm * BM + wr * 64 + fr, col0 = u.pn * BM + wc * 32 + 8 * fq;
        const int ci = 4 * (wc & 1) + fq;
        bool rope[2];
#pragma unroll
        for (int bj = 0; bj < 2; ++bj) { const int head = 4 * u.pn + 2 * bj + (wc >> 1); rope[bj] = (head < 8) || (head >= 22 && head < 34); }
        const bool anyrope = rope[0] || rope[1];
#pragma unroll
        for (int ai = 0; ai < 2; ++ai)
#pragma unroll
            for (int m = 0; m < 4; ++m) { const int row = row0 + ai * HALF + m * 16; bf16_t* rowp = O + (size_t)row * ldc + col0;
                f32x4 c4 = {1.f, 1.f, 1.f, 1.f}, s4 = {0.f, 0.f, 0.f, 0.f};
                if (anyrope) { const int s = row & seq_mask; c4 = *(const f32x4*)(cs + s * 32 + 4 * ci); s4 = *(const f32x4*)(sn + s * 32 + 4 * ci); }
#pragma unroll
                for (int bj = 0; bj < 2; ++bj) { f32x4 v0 = acc[ai][bj][m][0], v1 = acc[ai][bj][m][1];
                    if (rope[bj]) { const f32x4 y0 = v0 * c4 - v1 * s4, y1 = v0 * s4 + v1 * c4; v0 = y0; v1 = y1; }
                    u32x4 w; w.x = pk2(v0[0], v0[1]); w.y = pk2(v0[2], v0[3]); w.z = pk2(v1[0], v1[1]); w.w = pk2(v1[2], v1[3]);
                    *(u32x4*)(rowp + bj * HALF) = w; } }
    }
};

#define PG8_RLX_AGENT __ATOMIC_RELAXED, __HIP_MEMORY_SCOPE_AGENT
struct EpiAny {
    static constexpr bool PERM = true, AFTER_DRAIN = false;
    unsigned char* ws; const float* xin; float* outp; int mode; int l;
    __device__ __forceinline__ void prime(int pm, PG8_LAS unsigned char* lds, int tid) const {
        if (mode >= 3) return;
        if (tid < 256) { const f32x4 p = *(const f32x4*)((const float*)(ws + WS_PS2) + (size_t)(pm * BM + tid) * 4);
            ((PG8_LAS float*)(lds + 140288))[tid] = rsqrtf(((p[0] + p[1]) + (p[2] + p[3])) * (1.0f / 1024.0f) + NORM_EPS); }
    }
    __device__ __forceinline__ void operator()(const f32x4 (&acc)[2][2][4][2], const Unit& u, int wr, int wc, int fr, int fq, PG8_LAS unsigned char* lds, int wid, int lane, int next_pm, int parity) const {
        asm volatile("" : "+v"(fr), "+v"(fq));
        if (mode >= 3) { fused(acc, u, wr, wc, fr, fq, lds, wid, lane); return; }
        bf16_t* O = (bf16_t*)(ws + (mode == 1 ? WS_H : WS_PROJ)); const int ldc = (mode == 1) ? D_FF : PW, seq_mask = SEQ - 1;
        const float* cs = (const float*)(ws + WS_ROPE); const float* sn = cs + SEQ * 32; const float* rowss = (const float*)(ws + WS_PS2); const float eps = NORM_EPS;
        PG8_LAS float* RSC = (PG8_LAS float*)(lds + 140288); const int tid = wid * 64 + lane;
        f32x4 pnext = {0.f, 0.f, 0.f, 0.f};
        if (tid < 256 && next_pm >= 0) pnext = *(const f32x4*)(rowss + (size_t)(next_pm * BM + tid) * 4);
        const int row0 = u.pm * BM + wr * 64 + fr, col0 = u.pn * BM + wc * 32 + 8 * fq;
        const int ci = 4 * (wc & 1) + fq;
        bool rope[2];
#pragma unroll
        for (int bj = 0; bj < 2; ++bj) { const int head = 4 * u.pn + 2 * bj + (wc >> 1); rope[bj] = (mode == 2) && ((head < 8) || (head >= 22 && head < 34)); }
        const bool anyrope = rope[0] || rope[1];
#pragma unroll
        for (int ai = 0; ai < 2; ++ai) {
            f32x4 c4[4], s4[4]; float rsc[4];
#pragma unroll
            for (int m = 0; m < 4; ++m) { c4[m] = (f32x4){1.f, 1.f, 1.f, 1.f}; s4[m] = (f32x4){0.f, 0.f, 0.f, 0.f}; rsc[m] = 1.f; }
#pragma unroll
            for (int m = 0; m < 4; ++m) rsc[m] = RSC[parity * 256 + ai * HALF + wr * 64 + m * 16 + fr];
            if (anyrope) {
#pragma unroll
                for (int m = 0; m < 4; ++m) { const int s = (row0 + ai * HALF + m * 16) & seq_mask; c4[m] = *(const f32x4*)(cs + s * 32 + 4 * ci); s4[m] = *(const f32x4*)(sn + s * 32 + 4 * ci); } }
#pragma unroll
            for (int m = 0; m < 4; ++m) { const int row = row0 + ai * HALF + m * 16; bf16_t* rowp = O + (size_t)row * ldc + col0;
#pragma unroll
                for (int bj = 0; bj < 2; ++bj) { f32x4 v0 = acc[ai][bj][m][0] * rsc[m], v1 = acc[ai][bj][m][1] * rsc[m];
                    if (rope[bj]) { const f32x4 y0 = v0 * c4[m] - v1 * s4[m], y1 = v0 * s4[m] + v1 * c4[m]; v0 = y0; v1 = y1; }
                    if (mode == 1) {
#pragma unroll
                        for (int j = 0; j < 4; ++j) { const float a = fmaxf(v0[j], 0.f), b = fmaxf(v1[j], 0.f); v0[j] = a * a; v1[j] = b * b; } }
                    u32x4 w; w.x = pk2(v0[0], v0[1]); w.y = pk2(v0[2], v0[3]); w.z = pk2(v1[0], v1[1]); w.w = pk2(v1[2], v1[3]);
                    *(u32x4*)(rowp + bj * HALF) = w; } }
            asm volatile("" ::: "memory");
        }
        if (tid < 256 && next_pm >= 0) RSC[(parity ^ 1) * 256 + tid] = rsqrtf(((pnext[0] + pnext[1]) + (pnext[2] + pnext[3])) * (1.0f / 1024.0f) + eps);
    }
    __device__ __forceinline__ void fused(const f32x4 (&acc)[2][2][4][2], const Unit& u, int wr, int wc, int fr, int fq, PG8_LAS unsigned char* lds, int wid, int lane) const {
        asm volatile("" : "+v"(fr), "+v"(fq), "+v"(lane));
        const bool last = (mode == 4) && (l + 1 == DEPTH);
        bf16_t* xb = (bf16_t*)(ws + WS_XB); float* outf = last ? outp : nullptr;
        const float* gains = (const float*)(ws + WS_GAIN);
        const float* gpost = gains + (l * 4 + (mode == 3 ? 1 : 3)) * D_MODEL;
        float* ps1 = (float*)(ws + WS_PS1); float* ps2 = (float*)(ws + WS_PS2); unsigned* cnt = (unsigned*)(ws + WS_CNT) + (size_t)(2 * l + (mode == 4 ? 1 : 0)) * 256 * 16; const float eps = NORM_EPS;
        PG8_LAS float* P1 = (PG8_LAS float*)(lds + 131072);
        PG8_LAS float* S1 = (PG8_LAS float*)(lds + 131072 + 4096);
        PG8_LAS float* P2 = (PG8_LAS float*)(lds + 131072 + 5120);
        const int tid = wid * 64 + lane;
#pragma unroll
        for (int ai = 0; ai < 2; ++ai)
#pragma unroll
            for (int m = 0; m < 4; ++m) { float s = 0.f;
#pragma unroll
                for (int bj = 0; bj < 2; ++bj)
#pragma unroll
                    for (int n = 0; n < 2; ++n) { const f32x4 x = acc[ai][bj][m][n]; s += (x[0] * x[0] + x[1] * x[1]) + (x[2] * x[2] + x[3] * x[3]); }
                s += shx(s, 16); s += shx(s, 32);
                if (fq == 0) P1[(ai * HALF + wr * 64 + m * 16 + fr) * 4 + wc] = s; }
        asm volatile("s_waitcnt lgkmcnt(0)" ::: "memory"); __builtin_amdgcn_s_barrier(); asm volatile("" ::: "memory");
        if (tid < 256) { const f32x4 p = *(const PG8_LAS f32x4*)(P1 + tid * 4);
            __hip_atomic_store(ps1 + ((size_t)(u.pm * BM + tid)) * 4 + u.pn, (p[0] + p[1]) + (p[2] + p[3]), PG8_RLX_AGENT);
            asm volatile("s_waitcnt vmcnt(0)" ::: "memory");
            if (lane == 0) __hip_atomic_fetch_add(cnt + 16 * u.pm, 1u, PG8_RLX_AGENT); }
        if (wid == 0) { unsigned spins = 0;
            while ((unsigned)__builtin_amdgcn_readfirstlane((int)__hip_atomic_load(cnt + 16 * u.pm, PG8_RLX_AGENT)) < 16u) { __builtin_amdgcn_s_sleep(2); if (++spins > (1u << 21)) break; }
            __builtin_amdgcn_fence(__ATOMIC_ACQUIRE, "agent"); asm volatile("s_waitcnt vmcnt(0)" ::: "memory"); }
        asm volatile("s_waitcnt lgkmcnt(0)" ::: "memory"); __builtin_amdgcn_s_barrier(); asm volatile("" ::: "memory");
        if (tid < 256) { const float* q = ps1 + ((size_t)(u.pm * BM + tid)) * 4;
            const float t = (__hip_atomic_load(q, PG8_RLX_AGENT) + __hip_atomic_load(q + 1, PG8_RLX_AGENT)) + (__hip_atomic_load(q + 2, PG8_RLX_AGENT) + __hip_atomic_load(q + 3, PG8_RLX_AGENT));
            S1[tid] = rsqrtf(t * (1.0f / 1024.0f) + eps); }
        asm volatile("s_waitcnt lgkmcnt(0)" ::: "memory"); __builtin_amdgcn_s_barrier(); asm volatile("" ::: "memory");
        const int col0 = u.pn * BM + wc * 32 + 8 * fq;
        f32x4 g1[2][2];
#pragma unroll
        for (int bj = 0; bj < 2; ++bj)
#pragma unroll
            for (int n = 0; n < 2; ++n) { g1[bj][n] = *(const f32x4*)(gpost + col0 + bj * HALF + 4 * n); }
#pragma unroll
        for (int ai = 0; ai < 2; ++ai) {
            u32x4 xq[4][2];
#pragma unroll
            for (int m = 0; m < 4; ++m) { const size_t off = (size_t)(u.pm * BM + ai * HALF + wr * 64 + m * 16 + fr) * 1024 + col0;
#pragma unroll
                for (int bj = 0; bj < 2; ++bj) {
                    xq[m][bj] = *(const u32x4*)(xb + off + bj * HALF); } }
#pragma unroll
            for (int m = 0; m < 4; ++m) { const int rl = ai * HALF + wr * 64 + m * 16 + fr; const size_t off = (size_t)(u.pm * BM + rl) * 1024 + col0; const float rstd = S1[rl]; float s2 = 0.f;
#pragma unroll
                for (int bj = 0; bj < 2; ++bj) { f32x4 x0, x1;
                    { const u32x4 w = xq[m][bj];
                        x0 = (f32x4){__uint_as_float(w.x << 16), __uint_as_float(w.x & 0xffff0000u), __uint_as_float(w.y << 16), __uint_as_float(w.y & 0xffff0000u)};
                        x1 = (f32x4){__uint_as_float(w.z << 16), __uint_as_float(w.z & 0xffff0000u), __uint_as_float(w.w << 16), __uint_as_float(w.w & 0xffff0000u)}; }
                    f32x4 v0 = x0 + acc[ai][bj][m][0] * rstd * g1[bj][0], v1 = x1 + acc[ai][bj][m][1] * rstd * g1[bj][1];
                    if (outf) { float* op = outf + off + bj * HALF; *(f32x4*)op = v0; *(f32x4*)(op + 4) = v1; }
                    else { u32x4 w; w.x = pk2(v0[0], v0[1]); w.y = pk2(v0[2], v0[3]); w.z = pk2(v1[0], v1[1]); w.w = pk2(v1[2], v1[3]);
                        *(u32x4*)(xb + off + bj * HALF) = w;
                        v0 = (f32x4){__uint_as_float(w.x << 16), __uint_as_float(w.x & 0xffff0000u), __uint_as_float(w.y << 16), __uint_as_float(w.y & 0xffff0000u)};
                        v1 = (f32x4){__uint_as_float(w.z << 16), __uint_as_float(w.z & 0xffff0000u), __uint_as_float(w.w << 16), __uint_as_float(w.w & 0xffff0000u)};
                        s2 += ((v0[0] * v0[0] + v0[1] * v0[1]) + (v0[2] * v0[2] + v0[3] * v0[3])) + ((v1[0] * v1[0] + v1[1] * v1[1]) + (v1[2] * v1[2] + v1[3] * v1[3]));
                    } }
                if (!outf) { s2 += shx(s2, 16); s2 += shx(s2, 32); if (fq == 0) P2[rl * 4 + wc] = s2; } }
            asm volatile("" ::: "memory");
        }
        if (!outf) {
            asm volatile("s_waitcnt lgkmcnt(0)" ::: "memory"); __builtin_amdgcn_s_barrier(); asm volatile("" ::: "memory");
            if (tid < 256) { const f32x4 p = *(const PG8_LAS f32x4*)(P2 + tid * 4); ps2[((size_t)(u.pm * BM + tid)) * 4 + u.pn] = (p[0] + p[1]) + (p[2] + p[3]); } }
    }
};
template <class Epi, class Sched, bool ALIGN_EPI = false, bool SP2 = false>
__device__ __forceinline__ void gemm_phase(PG8_LAS unsigned char* lds, const Gemm g, const Sched& S, const Epi& E, const int tid) {
    const int wid = __builtin_amdgcn_readfirstlane(tid >> 6), lane = tid & 63, wr = wid >> 2, wc = wid & 3, fr = lane & 15, fq = lane >> 4;
    const int K = g.K, nt = K / BK;
    unsigned voffA[2], voffB[2];
#pragma unroll
    for (int i = 0; i < 2; ++i) { int R, C; stage_rc(tid * 16 + i * 8192, R, C); const int Rb = Epi::PERM ? ((R & ~31) + perm32(R & 31)) : R;
        voffA[i] = (unsigned)(R * K + C) * 2u; voffB[i] = (unsigned)(Rb * K + C) * 2u; }
    const size_t kstep = (size_t)(BK * 2);
    const size_t hstep = (size_t)HALF * K * 2;
    const size_t tstep = 2 * hstep;
    const unsigned ldsw = (unsigned)wid * 1024u;
    const int aoff = lds_byte(wr * 64 + fr, fq * 8), boff = lds_byte(wc * 32 + fr, fq * 8);
#define PG8_SA(b, h) (((b) * 2 + (h)) * HTB)
#define PG8_SB(b, h) ((4 + (b) * 2 + (h)) * HTB)
#define PG8_STAGE(bufoff, gbase, voff) do { _Pragma("unroll") for (int _i = 0; _i < 2; ++_i) \
        __builtin_amdgcn_global_load_lds((const unsigned*)((const char*)(gbase) + (voff)[_i]), (PG8_LAS unsigned*)(lds + (bufoff) + ldsw + _i * 8192), 16, 0, 0); } while (0)
#define PG8_LDA(dst, b, h) do { _Pragma("unroll") for (int m = 0; m < 4; ++m) _Pragma("unroll") for (int k = 0; k < 2; ++k) dst[m][k] = *(const PG8_LAS bf16x8*)(lds + PG8_SA(b, h) + aoff + m * 2048 + k * 1024); } while (0)
#define PG8_LDB(dst, b, h) do { _Pragma("unroll") for (int n = 0; n < 2; ++n) _Pragma("unroll") for (int k = 0; k < 2; ++k) dst[n][k] = *(const PG8_LAS bf16x8*)(lds + PG8_SB(b, h) + boff + n * 2048 + k * 1024); } while (0)
#define PG8_MMA(ai, bj, At, Bt) do { __builtin_amdgcn_s_setprio(1); _Pragma("unroll") for (int m = 0; m < 4; ++m) _Pragma("unroll") for (int n = 0; n < 2; ++n) _Pragma("unroll") for (int k = 0; k < 2; ++k) \
        acc[ai][bj][m][n] = __builtin_amdgcn_mfma_f32_16x16x32_bf16(Bt[n][k], At[m][k], acc[ai][bj][m][n], 0, 0, 0); __builtin_amdgcn_s_setprio(0); } while (0)
#define PG8_WAIT_V(n) asm volatile("s_waitcnt vmcnt(" #n ")" ::: "memory")
#define PG8_WAIT_L(n) asm volatile("s_waitcnt lgkmcnt(" #n ")" ::: "memory")
#define PG8_BAR __builtin_amdgcn_s_barrier()
#define PG8_SCHED __builtin_amdgcn_sched_barrier(0)
    Unit cur, nxt; int ui = 0;
    if (!S.next(0, cur)) return;
    f32x4 acc[2][2][4][2];
#pragma unroll
    for (int a = 0; a < 2; ++a)
#pragma unroll
        for (int b = 0; b < 2; ++b)
#pragma unroll
            for (int m = 0; m < 4; ++m)
#pragma unroll
                for (int n = 0; n < 2; ++n) acc[a][b][m][n] = (f32x4){0.f, 0.f, 0.f, 0.f};
    bf16x8 At[4][2], B0[2][2], B1[2][2];
    const char* cA = (const char*)g.A + (size_t)cur.pm * tstep; const char* cB = (const char*)g.Bt + (size_t)cur.pn * tstep;
    S.a_ready(cur);
    E.prime(cur.pm, lds, wid * 64 + lane);
    if constexpr (SP2) {
        PG8_STAGE(PG8_SB(0, 0), cB, voffB); PG8_STAGE(PG8_SB(0, 1), cB + hstep, voffB); PG8_STAGE(PG8_SA(0, 0), cA, voffA); PG8_STAGE(PG8_SA(0, 1), cA + hstep, voffA);
        if (wr == 1) PG8_BAR;
        PG8_WAIT_V(2); PG8_BAR;
        PG8_STAGE(PG8_SB(1, 0), cB + kstep, voffB); PG8_STAGE(PG8_SA(1, 0), cA + kstep, voffA); PG8_STAGE(PG8_SB(1, 1), cB + hstep + kstep, voffB);
        PG8_WAIT_V(6); PG8_BAR;
    } else {
        PG8_STAGE(PG8_SB(0, 0), cB, voffB); PG8_STAGE(PG8_SA(0, 0), cA, voffA); PG8_STAGE(PG8_SB(0, 1), cB + hstep, voffB); PG8_STAGE(PG8_SA(0, 1), cA + hstep, voffA);
        if (wr == 1) PG8_BAR;
        PG8_WAIT_V(4); PG8_BAR;
        PG8_STAGE(PG8_SB(1, 0), cB + kstep, voffB); PG8_STAGE(PG8_SA(1, 0), cA + kstep, voffA); PG8_STAGE(PG8_SB(1, 1), cB + hstep + kstep, voffB);
        PG8_WAIT_V(6); PG8_BAR;
    }
    for (;;) {
        const bool has_next = S.next(ui + 1, nxt);
        const char* nA = has_next ? (const char*)g.A + (size_t)nxt.pm * tstep : cA; const char* nB = has_next ? (const char*)g.Bt + (size_t)nxt.pn * tstep : cB;
        for (int t = 0; t < nt; t += 2) {
            const bool last = (t == nt - 2);
            const char* a1 = cA + (size_t)(t + 1) * kstep;
            const char* a2 = last ? nA : cA + (size_t)(t + 2) * kstep; const char* b2 = last ? nB : cB + (size_t)(t + 2) * kstep;
            const char* a3 = a2 + kstep; const char* b3 = b2 + kstep;
            if (last && has_next) S.a_ready(nxt);
            if constexpr (SP2) {
            PG8_LDB(B0, 0, 0); PG8_LDB(B1, 0, 1); PG8_SCHED; PG8_LDA(At, 0, 0); PG8_STAGE(PG8_SA(1, 1), a1 + hstep, voffA);
            PG8_WAIT_V(8); PG8_WAIT_L(0); PG8_BAR; PG8_MMA(0, 0, At, B0); PG8_MMA(0, 1, At, B1); PG8_BAR; PG8_SCHED;
            PG8_LDA(At, 0, 1); PG8_STAGE(PG8_SB(0, 0), b2, voffB); PG8_STAGE(PG8_SB(0, 1), b2 + hstep, voffB); PG8_STAGE(PG8_SA(0, 0), a2, voffA);
            PG8_WAIT_V(8); PG8_WAIT_L(0); PG8_BAR; PG8_MMA(1, 0, At, B0); PG8_MMA(1, 1, At, B1); PG8_BAR; PG8_SCHED;
            PG8_LDB(B0, 1, 0); PG8_LDB(B1, 1, 1); PG8_SCHED; PG8_LDA(At, 1, 0); PG8_STAGE(PG8_SA(0, 1), a2 + hstep, voffA);
            PG8_WAIT_V(8); PG8_WAIT_L(0); PG8_BAR; PG8_MMA(0, 0, At, B0); PG8_MMA(0, 1, At, B1); PG8_BAR; PG8_SCHED;
            PG8_LDA(At, 1, 1); PG8_STAGE(PG8_SB(1, 0), b3, voffB); PG8_STAGE(PG8_SB(1, 1), b3 + hstep, voffB); PG8_STAGE(PG8_SA(1, 0), a3, voffA);
            PG8_WAIT_V(8); PG8_WAIT_L(0); PG8_BAR; PG8_MMA(1, 0, At, B0); PG8_MMA(1, 1, At, B1); PG8_BAR; PG8_SCHED;
            } else {
            PG8_LDB(B0, 0, 0); PG8_SCHED; PG8_LDA(At, 0, 0); PG8_STAGE(PG8_SA(1, 1), a1 + hstep, voffA);
            PG8_WAIT_L(8); PG8_BAR; PG8_WAIT_L(0); PG8_MMA(0, 0, At, B0); PG8_BAR; PG8_SCHED;
            PG8_LDB(B1, 0, 1); PG8_STAGE(PG8_SB(0, 0), b2, voffB);
            PG8_BAR; PG8_WAIT_L(0); PG8_MMA(0, 1, At, B1); PG8_BAR;
            PG8_LDA(At, 0, 1); PG8_STAGE(PG8_SA(0, 0), a2, voffA);
            PG8_BAR; PG8_WAIT_L(0); PG8_MMA(1, 0, At, B0); PG8_BAR; PG8_SCHED;
            PG8_STAGE(PG8_SB(0, 1), b2 + hstep, voffB);
            PG8_WAIT_V(6); PG8_BAR; PG8_MMA(1, 1, At, B1); PG8_BAR;
            PG8_LDB(B0, 1, 0); PG8_SCHED; PG8_LDA(At, 1, 0); PG8_STAGE(PG8_SA(0, 1), a2 + hstep, voffA);
            PG8_WAIT_L(8); PG8_BAR; PG8_WAIT_L(0); PG8_MMA(0, 0, At, B0); PG8_BAR; PG8_SCHED;
            PG8_LDB(B1, 1, 1); PG8_STAGE(PG8_SB(1, 0), b3, voffB);
            PG8_BAR; PG8_WAIT_L(0); PG8_MMA(0, 1, At, B1); PG8_BAR;
            PG8_LDA(At, 1, 1); PG8_STAGE(PG8_SA(1, 0), a3, voffA);
            PG8_BAR; PG8_WAIT_L(0); PG8_MMA(1, 0, At, B0); PG8_BAR; PG8_SCHED;
            PG8_STAGE(PG8_SB(1, 1), b3 + hstep, voffB);
            PG8_WAIT_V(6); PG8_BAR; PG8_MMA(1, 1, At, B1); PG8_BAR;
            }
        }
        if constexpr (ALIGN_EPI) { if (wr == 0) PG8_BAR; }
        if constexpr (!Epi::AFTER_DRAIN) { E(acc, cur, wr, wc, fr, fq, lds, wid, lane, has_next ? nxt.pm : -1, ui & 1); S.done(cur); }
        if (!has_next) break;
#pragma unroll
        for (int a = 0; a < 2; ++a)
#pragma unroll
            for (int b = 0; b < 2; ++b)
#pragma unroll
                for (int m = 0; m < 4; ++m)
#pragma unroll
                    for (int n = 0; n < 2; ++n) acc[a][b][m][n] = (f32x4){0.f, 0.f, 0.f, 0.f};
        cur = nxt; cA = nA; cB = nB; ++ui;
        if constexpr (ALIGN_EPI) { if (wr == 1) PG8_BAR; }
    }
    PG8_WAIT_V(0);
    if constexpr (!ALIGN_EPI) { if (wr == 0) PG8_BAR; }
    PG8_BAR;
    if constexpr (Epi::AFTER_DRAIN) { E.fused(acc, cur, wr, wc, fr, fq, lds, wid, lane); S.done(cur); }
#undef PG8_SA
#undef PG8_SB
#undef PG8_STAGE
#undef PG8_LDA
#undef PG8_LDB
#undef PG8_MMA
#undef PG8_WAIT_V
#undef PG8_WAIT_L
#undef PG8_BAR
#undef PG8_SCHED
}
}
#define LAS __attribute__((address_space(3)))
typedef LAS unsigned char* ldsp;
typedef unsigned short bf16_t;
typedef short bf16x8 __attribute__((ext_vector_type(8)));
typedef short s16x4 __attribute__((ext_vector_type(4)));
typedef float f32x4 __attribute__((ext_vector_type(4)));
typedef float f32x16 __attribute__((ext_vector_type(16)));
typedef unsigned u32x4 __attribute__((ext_vector_type(4)));
typedef unsigned u32x2 __attribute__((ext_vector_type(2)));
using pg8::pk2;
#define DI __device__ __forceinline__
#define LDS_WAIT() asm volatile("s_waitcnt lgkmcnt(0)" ::: "memory")

DI f32x16 mfma32(bf16x8 a, bf16x8 b, f32x16 c) { return __builtin_amdgcn_mfma_f32_32x32x16_bf16(a, b, c, 0, 0, 0); }
DI constexpr int crow(int i, int h) { return (i & 3) + 8 * (i >> 2) + 4 * h; }
DI float bf2f(unsigned short b) { return __uint_as_float(((unsigned)b) << 16); }
DI f32x16 zero16() { f32x16 z;
#pragma unroll
  for (int i = 0; i < 16; ++i) z[i] = 0.f; return z; }
DI bf16x8 pack8(const f32x16& x, const int s) { u32x4 p; p.x = pk2(x[8 * s], x[8 * s + 1]); p.y = pk2(x[8 * s + 2], x[8 * s + 3]); p.z = pk2(x[8 * s + 4], x[8 * s + 5]); p.w = pk2(x[8 * s + 6], x[8 * s + 7]); return __builtin_bit_cast(bf16x8, p); }
DI float lg2gamma(int head) { return log2f(1.0f - exp2f(-5.0f - (float)head)); }
DI int launder(int x) { asm volatile("" : "+v"(x)); return x; }
template <int CTRL> DI float dpp_add(float v) { return v + __int_as_float(__builtin_amdgcn_update_dpp(0, __float_as_int(v), CTRL, 0xF, 0xF, true)); }
DI float wave_sum(float v) {
    v = dpp_add<0xB1>(v);
    v = dpp_add<0x4E>(v);
    v = dpp_add<0x141>(v);
    v = dpp_add<0x140>(v);
    v += __int_as_float(__builtin_amdgcn_ds_swizzle(__float_as_int(v), 0x401F));
    v += shx(v, 32);
    return v; }

#define XB_TMO      128
#define XB_XCNT(j)  (256  + 64 * (j))
#define XB_XSUB(j)  (1280 + 64 * (j))
#define XB_XGEN(j)  (2304 + 64 * (j))
#define XB_TOP      3328
#define XB_TOPGEN   3392
#define XCD_BAR_WORDS 3456
#define XB_SPIN_CAP (1u << 18)

__device__ __forceinline__ unsigned xb_ld(unsigned* p)              { return __hip_atomic_load(p, __ATOMIC_RELAXED, __HIP_MEMORY_SCOPE_AGENT); }
__device__ __forceinline__ unsigned xb_add(unsigned* p, unsigned v) { return __hip_atomic_fetch_add(p, v, __ATOMIC_RELAXED, __HIP_MEMORY_SCOPE_AGENT); }
__device__ __forceinline__ unsigned xb_xcc_id() { return (unsigned)__builtin_amdgcn_s_getreg((3 << 11) | 20) & 0xFu; }
#define XB_SPIN(cond, bar) do { unsigned _sp = 0; while (cond) { __builtin_amdgcn_s_sleep(1); \
    if ((++_sp & 255u) == 0u) { if (xb_ld(&(bar)[XB_TMO])) break; if (_sp > XB_SPIN_CAP) { atomicAdd(&(bar)[XB_TMO], 1u); break; } } } } while (0)

struct XcdBarrier {
    unsigned* bar; unsigned x;
    volatile LAS unsigned* st;
};

__device__ __forceinline__ XcdBarrier xcd_barrier_post(unsigned* bar, volatile LAS unsigned* st) {
    XcdBarrier b; b.bar = bar; b.x = xb_xcc_id(); b.st = st;
    if (threadIdx.x == 0) (void)xb_add(&bar[XB_XCNT(b.x)], 1u);
    return b;
}
__device__ __forceinline__ void xcd_barrier_complete(unsigned* bar, unsigned x, unsigned& nloc, unsigned& nx) {
    const unsigned G = gridDim.x * gridDim.y * gridDim.z;
    unsigned sum, cnt, mine, sp = 0u;
    for (;;) {
        sum = 0u; cnt = 0u; mine = 0u;
#pragma unroll
        for (unsigned j = 0; j < 16; ++j) { const unsigned c = xb_ld(&bar[XB_XCNT(j)]); sum += c; cnt += (c > 0u) ? 1u : 0u; mine = (j == x) ? c : mine; }
        if (sum == G) break;
        __builtin_amdgcn_s_sleep(1);
        if ((++sp & 255u) == 0u) { if (xb_ld(&bar[XB_TMO])) break; if (sp > XB_SPIN_CAP) { atomicAdd(&bar[XB_TMO], 1u); break; } }
    }
    nloc = mine > 0u ? mine : 1u; nx = cnt > 0u ? cnt : 1u;
}

__device__ __forceinline__ void xcd_barrier(const XcdBarrier& b) {
    asm volatile("s_waitcnt vmcnt(0)" ::: "memory");
    __syncthreads();
    if (threadIdx.x == 0) {
        unsigned* bar = b.bar;
        __builtin_amdgcn_s_waitcnt(0);
        unsigned nloc = b.st[0], nx = b.st[1];
        if (nloc == 0u) { xcd_barrier_complete(bar, b.x, nloc, nx); b.st[0] = nloc; b.st[1] = nx; }
        const unsigned old = xb_add(&bar[XB_XSUB(b.x)], 1u);
        const unsigned gen = old / nloc;
        if (old + 1u == (gen + 1u) * nloc) {
            __builtin_amdgcn_fence(__ATOMIC_RELEASE, "agent");
            asm volatile("s_waitcnt vmcnt(0)" ::: "memory");
            const unsigned og = xb_add(&bar[XB_TOP], 1u);
            const unsigned tg = og / nx;
            if (og + 1u == (tg + 1u) * nx) xb_add(&bar[XB_TOPGEN], 1u);
            else XB_SPIN(xb_ld(&bar[XB_TOPGEN]) == tg, bar);
            __builtin_amdgcn_fence(__ATOMIC_ACQUIRE, "agent");
            xb_add(&bar[XB_XGEN(b.x)], 1u);
            asm volatile("s_waitcnt vmcnt(0)" ::: "memory");
        } else {
            XB_SPIN(xb_ld(&bar[XB_XGEN(b.x)]) == gen, bar);
            __builtin_amdgcn_fence(__ATOMIC_ACQUIRE, "agent");
            asm volatile("s_waitcnt vmcnt(0)" ::: "memory");
        }
    }
    __syncthreads();
}

DI void stage_rows(ldsp dst, const bf16_t* src, size_t pitch, int nrows, int tid) {
    for (int it = tid; it < nrows * 8; it += NTHREADS) { const int r = it >> 3, c = it & 7;
        const u32x4 v = *(const u32x4*)(src + (size_t)r * pitch + c * 8);
        *(LAS u32x4*)(dst + r * 144 + c * 16) = v; }
}
template <int NT> DI void stage_tiles(ldsp lds, const int (&dstoff)[NT], const bf16_t* const (&src)[NT], const float (&lg)[NT], int tid) {
    u32x4 v[NT][2];
    const int r0 = tid >> 3, c = tid & 7;
#pragma unroll
    for (int t = 0; t < NT; ++t)
#pragma unroll
        for (int i = 0; i < 2; ++i) v[t][i] = *(const u32x4*)(src[t] + (size_t)(r0 + 64 * i) * PW + c * 8);
#pragma unroll
    for (int t = 0; t < NT; ++t)
#pragma unroll
        for (int i = 0; i < 2; ++i) { u32x4 o = v[t][i];
            if (lg[t] != 0.f) { const float sc = exp2f((float)(127 - (r0 + 64 * i)) * lg[t]);
                o.x = pk2(__uint_as_float(o.x << 16) * sc, __uint_as_float(o.x & 0xffff0000u) * sc); o.y = pk2(__uint_as_float(o.y << 16) * sc, __uint_as_float(o.y & 0xffff0000u) * sc);
                o.z = pk2(__uint_as_float(o.z << 16) * sc, __uint_as_float(o.z & 0xffff0000u) * sc); o.w = pk2(__uint_as_float(o.w << 16) * sc, __uint_as_float(o.w & 0xffff0000u) * sc); }
            *(LAS u32x4*)(lds + dstoff[t] + (r0 + 64 * i) * 144 + c * 16) = o; }
}
DI void stage_rows_scaled(ldsp dst, const bf16_t* src, size_t pitch, int nrows, int tid, float lg) {
    for (int it = tid; it < nrows * 8; it += NTHREADS) { const int r = it >> 3, c = it & 7;
        const u32x4 v = *(const u32x4*)(src + (size_t)r * pitch + c * 8); const float sc = exp2f((float)(127 - r) * lg);
        u32x4 o; o.x = pk2(__uint_as_float(v.x << 16) * sc, __uint_as_float(v.x & 0xffff0000u) * sc); o.y = pk2(__uint_as_float(v.y << 16) * sc, __uint_as_float(v.y & 0xffff0000u) * sc);
        o.z = pk2(__uint_as_float(v.z << 16) * sc, __uint_as_float(v.z & 0xffff0000u) * sc); o.w = pk2(__uint_as_float(v.w << 16) * sc, __uint_as_float(v.w & 0xffff0000u) * sc);
        *(LAS u32x4*)(dst + r * 144 + c * 16) = o; }
}
template <bool SCALE> DI void stage_T(ldsp dst, int stride, int key0, const bf16_t* src, size_t pitch, int nrows, int tid, float lg) {
    for (int it = tid; it < nrows * 8; it += NTHREADS) { const int r = it >> 3, c = it & 7;
        const u32x4 v = *(const u32x4*)(src + (size_t)r * pitch + c * 8);
        unsigned w[4] = {v.x, v.y, v.z, v.w};
        float sc = 1.f; if (SCALE) sc = exp2f((float)(127 - r) * lg);
#pragma unroll
        for (int j = 0; j < 8; ++j) { unsigned short e = (unsigned short)((j & 1) ? (w[j >> 1] >> 16) : (w[j >> 1] & 0xffffu));
            if (SCALE) { e = (unsigned short)(pk2(bf2f(e) * sc, 0.f) & 0xffffu); }
            *(LAS unsigned short*)(dst + ((8 * c + j) * stride + key0 + r) * 2) = e; } }
}
DI bf16x8 kfrag(ldsp Kb, int row, int kk, int h) { return *(const LAS bf16x8*)(Kb + row * 144 + (16 * kk + 8 * h) * 2); }
DI bf16x8 vtfrag_perm(ldsp Vb, int stride, int row, int key0, int h) {
    const s16x4 lo = *(const LAS s16x4*)(Vb + (row * stride + key0 + 4 * h) * 2), hi = *(const LAS s16x4*)(Vb + (row * stride + key0 + 8 + 4 * h) * 2);
    return __builtin_shufflevector(lo, hi, 0, 1, 2, 3, 4, 5, 6, 7); }
DI int vt_lane_off(int lane) { const int i = lane & 15; return (i >> 2) * 144 + (16 * ((lane >> 4) & 1) + 4 * (i & 3)) * 2; }
DI s16x4 tr_read(ldsp p) { return __builtin_amdgcn_ds_read_tr16_b64_v4i16((LAS s16x4*)p); }
DI bf16x8 vfrag_perm_tr(ldsp Vb, int loff, int col0, int key0, int h) {
    ldsp p = Vb + (key0 + 4 * h) * 144 + col0 * 2 + loff;
    const s16x4 lo = tr_read(p), hi = tr_read(p + 8 * 144);
    return __builtin_shufflevector(lo, hi, 0, 1, 2, 3, 4, 5, 6, 7); }
DI bf16x8 vfrag_nat_tr(ldsp Vb, int loff, int col0, int key0, int h) {
    ldsp p = Vb + (key0 + 8 * h) * 144 + col0 * 2 + loff;
    const s16x4 lo = tr_read(p), hi = tr_read(p + 4 * 144);
    return __builtin_shufflevector(lo, hi, 0, 1, 2, 3, 4, 5, 6, 7); }
DI bf16x8 vtfrag_nat(ldsp Vb, int stride, int row, int key0, int h) {
    const s16x4 lo = *(const LAS s16x4*)(Vb + (row * stride + key0 + 8 * h) * 2), hi = *(const LAS s16x4*)(Vb + (row * stride + key0 + 8 * h + 4) * 2);
    return __builtin_shufflevector(lo, hi, 0, 1, 2, 3, 4, 5, 6, 7); }

DI void swa_unit(ldsp lds, int u, const bf16_t* PROJ, bf16_t* MIXED, const float* sinks, const float* ga, int tid) {
    tid = launder(tid);
    const int b = u >> 6, nb = u & 63;
    const size_t tok0 = (size_t)b * SEQ + (size_t)nb * 128, prev0 = nb > 0 ? tok0 - 128 : tok0;
    ldsp Ks = lds, VTs = lds + 73728; LAS float* xs = (LAS float*)(lds + 147456);
    __syncthreads();
    {   const int dsto[8] = {0, 128 * 144, 36864, 36864 + 128 * 144, 73728, 73728 + 128 * 144, 73728 + 36864, 73728 + 36864 + 128 * 144};
        const bf16_t* const srcs[8] = {PROJ + prev0 * PW + C_KA, PROJ + tok0 * PW + C_KA, PROJ + prev0 * PW + C_KA + 64, PROJ + tok0 * PW + C_KA + 64,
                                       PROJ + prev0 * PW + C_VA, PROJ + tok0 * PW + C_VA, PROJ + prev0 * PW + C_VA + 64, PROJ + tok0 * PW + C_VA + 64};
        const float lgs[8] = {0.f, 0.f, 0.f, 0.f, 0.f, 0.f, 0.f, 0.f};
        stage_tiles<8>(lds, dsto, srcs, lgs, tid); }
    __syncthreads();
    const int wave = __builtin_amdgcn_readfirstlane(tid >> 6), lane = tid & 63, rt = wave & 3, hk = wave >> 2, qi = lane & 31, h = lane >> 5;
    const int qrow = 32 * rt + qi; const size_t token = tok0 + qrow;
    ldsp Kh = Ks + hk * 36864, Vh = VTs + hk * 36864; const int loff = vt_lane_off(lane);
    u32x2 Op[3][2][4]; float ssq = 0.f;
#pragma unroll
    for (int hh = 0; hh < 3; ++hh) {
        const int head = 3 * hk + hh; f32x16 O[2];
        bf16x8 q[4];
#pragma unroll
        for (int kk = 0; kk < 4; ++kk) q[kk] = *(const bf16x8*)(PROJ + token * PW + C_QA + head * 64 + 16 * kk + 8 * h);
        const float sink = sinks[head]; float mx = sink, den = 1.0f;
        O[0] = zero16(); O[1] = zero16();
#pragma unroll
        for (int ti = 0; ti < 5; ++ti) {
            f32x16 s = zero16();
#pragma unroll
            for (int kk = 0; kk < 4; ++kk) s = mfma32(kfrag(Kh, 32 * (rt + ti) + qi, kk, h), q[kk], s);
            float tm = -INFINITY;
            const int kb0 = 32 * (rt + ti) + 4 * h, lo_t = launder(max(qrow, nb > 0 ? -1 : 127) - kb0), hi_t = launder(128 + qrow - kb0);
#pragma unroll
            for (int i = 0; i < 16; ++i) { const int c = (i & 3) + 8 * (i >> 2);
                const bool valid = (c > lo_t) && (c <= hi_t);
                const float v = valid ? s[i] : -INFINITY; s[i] = v; tm = fmaxf(tm, v); }
            tm = fmaxf(tm, shx(tm, 32));
            const float mn = fmaxf(mx, tm), sc = __expf(mx - mn); mx = mn;
            float ps = 0.f;
#pragma unroll
            for (int i = 0; i < 16; ++i) { const float p = __expf(s[i] - mn); s[i] = p; ps += p; }
            den = den * sc + ps;
#pragma unroll
            for (int dd = 0; dd < 2; ++dd)
#pragma unroll
                for (int i = 0; i < 16; ++i) O[dd][i] *= sc;
#pragma unroll
            for (int s2 = 0; s2 < 2; ++s2) { const bf16x8 P = pack8(s, s2);
#pragma unroll
                for (int dd = 0; dd < 2; ++dd) O[dd] = mfma32(vfrag_perm_tr(Vh, loff, 32 * dd, 32 * (rt + ti) + 16 * s2, h), P, O[dd]); }
            asm volatile("" ::: "memory");
        }
        den += shx(den, 32) - __expf(sink - mx);
        const float inv = 1.0f / den;
#pragma unroll
        for (int dd = 0; dd < 2; ++dd)
#pragma unroll
            for (int i = 0; i < 16; ++i) { const float o = O[dd][i] * inv; O[dd][i] = o; ssq += o * o; }
#pragma unroll
        for (int dd = 0; dd < 2; ++dd)
#pragma unroll
            for (int g = 0; g < 4; ++g) { Op[hh][dd][g].x = pk2(O[dd][4 * g], O[dd][4 * g + 1]); Op[hh][dd][g].y = pk2(O[dd][4 * g + 2], O[dd][4 * g + 3]); }
    }
    ssq += shx(ssq, 32);
    if (h == 0) xs[hk * 128 + qrow] = ssq;
    __syncthreads();
    const float rstd = rsqrtf((xs[qrow] + xs[128 + qrow]) * (1.0f / 384.0f) + NORM_EPS);
#pragma unroll
    for (int hh = 0; hh < 3; ++hh)
#pragma unroll
        for (int dd = 0; dd < 2; ++dd)
#pragma unroll
            for (int g = 0; g < 4; ++g) { const int col = (3 * hk + hh) * 64 + 32 * dd + 8 * g + 4 * h; const f32x4 gg = *(const f32x4*)(ga + col);
                const u32x2 pk = Op[hh][dd][g]; const float o0 = __uint_as_float(pk.x << 16), o1 = __uint_as_float(pk.x & 0xffff0000u), o2 = __uint_as_float(pk.y << 16), o3 = __uint_as_float(pk.y & 0xffff0000u);
                u32x2 w; w.x = pk2(o0 * rstd * gg[0], o1 * rstd * gg[1]); w.y = pk2(o2 * rstd * gg[2], o3 * rstd * gg[3]);
                *(u32x2*)(MIXED + token * D_MODEL + col) = w; }
}

DI float sb_tile(ldsp Kh, ldsp Vh, int loff, const bf16x8 (&q)[4], f32x16 (&O)[2], float R, int kt, bool diag, int qi, int h) {
    f32x16 z = zero16();
#pragma unroll
    for (int kk = 0; kk < 4; ++kk) z = mfma32(kfrag(Kh, 32 * kt + qi, kk, h), q[kk], z);
    const int lim = launder(diag ? (qi - 4 * h) : 64);
    float lb[16], v[16];
#pragma unroll
    for (int i = 0; i < 16; ++i) { const float zz = z[i], e = __expf(-fabsf(zz)), l = fminf(zz, 0.f) - __logf(1.0f + e);
        const bool strict = ((i & 3) + 8 * (i >> 2)) < lim; lb[i] = l; v[i] = strict ? (l - zz) : 0.f; }
    float t[16], G[4], P[4], off[4];
#pragma unroll
    for (int g = 0; g < 4; ++g) { t[4 * g + 3] = 0.f; t[4 * g + 2] = v[4 * g + 3]; t[4 * g + 1] = t[4 * g + 2] + v[4 * g + 2]; t[4 * g] = t[4 * g + 1] + v[4 * g + 1]; G[g] = t[4 * g] + v[4 * g]; }
#pragma unroll
    for (int g = 0; g < 4; ++g) P[g] = shx(G[g], 32);
    float run = 0.f;
#pragma unroll
    for (int g = 3; g >= 0; --g) { off[g] = h ? run : (run + P[g]); run += (G[g] + P[g]); }
#pragma unroll
    for (int i = 0; i < 16; ++i) { const bool strict = ((i & 3) + 8 * (i >> 2)) < lim;
        const float w = strict ? __expf(lb[i] + t[i] + off[i >> 2] + R) : 0.f; z[i] = w; }
#pragma unroll
    for (int s2 = 0; s2 < 2; ++s2) { const bf16x8 Pk = pack8(z, s2);
#pragma unroll
        for (int dd = 0; dd < 2; ++dd) O[dd] = mfma32(vfrag_perm_tr(Vh, loff, 32 * dd, 32 * kt + 16 * s2, h), Pk, O[dd]); }
    return R + run;
}
DI void sb_unit(ldsp lds, int u, const bf16_t* PROJ, bf16_t* MIXED, const float* gb, int tid) {
    tid = launder(tid);
    const int b = u >> 6, nb = u & 63;
    const size_t tok0 = (size_t)b * SEQ + (size_t)nb * 128;
    ldsp Ks = lds, VTs = lds + 73728; LAS int* flags = (LAS int*)(lds + 147456); LAS float* xs = (LAS float*)(lds + 147456 + 64);
    const int wave = __builtin_amdgcn_readfirstlane(tid >> 6), lane = tid & 63, p = wave & 3, hs = wave >> 2, qi = lane & 31, h = lane >> 5;
    const int loff = vt_lane_off(lane);
    bf16x8 q[2][4]; f32x16 O[2][2]; float R[2]; bool live[2];
#pragma unroll
    for (int it = 0; it < 2; ++it) { const int head = 2 * hs + it, rt = it ? 3 - p : p; const size_t token = tok0 + 32 * rt + qi;
#pragma unroll
        for (int kk = 0; kk < 4; ++kk) q[it][kk] = *(const bf16x8*)(PROJ + token * PW + C_QB + head * 64 + 16 * kk + 8 * h);
        O[it][0] = zero16(); O[it][1] = zero16(); R[it] = 0.f; live[it] = true; }
    int iter = 0;
    for (int kb = nb; kb >= 0; --kb) {
        __syncthreads();
        const size_t kt0 = (size_t)b * SEQ + (size_t)kb * 128;
        {   const int dsto[8] = {0, 18432, 36864, 55296, 73728, 73728 + 18432, 73728 + 36864, 73728 + 55296};
            const bf16_t* kp = PROJ + kt0 * PW + C_KB; const bf16_t* vp = PROJ + kt0 * PW + C_VB;
            const bf16_t* const srcs[8] = {kp, kp + 64, kp + 128, kp + 192, vp, vp + 64, vp + 128, vp + 192};
            const float lgs[8] = {0.f, 0.f, 0.f, 0.f, 0.f, 0.f, 0.f, 0.f};
            stage_tiles<8>(lds, dsto, srcs, lgs, tid); }
        __syncthreads();
#pragma unroll
        for (int it = 0; it < 2; ++it) {
            if (live[it]) { const int head = 2 * hs + it, rt = it ? 3 - p : p; ldsp Kh = Ks + head * 18432, Vh = VTs + head * 18432;
                for (int kt = (kb == nb) ? rt : 3; kt >= 0; --kt) {
                    R[it] = sb_tile(Kh, Vh, loff, q[it], O[it], R[it], kt, (kb == nb) && (kt == rt), qi, h);
                    if (__all(R[it] < SB_THR)) { live[it] = false; break; }
                }
            }
        }
        if (lane == 0) flags[(iter & 1) * 8 + wave] = (live[0] || live[1]) ? 1 : 0;
        __syncthreads();
        int any = 0;
#pragma unroll
        for (int w2 = 0; w2 < 8; ++w2) any |= flags[(iter & 1) * 8 + w2];
        ++iter;
        if (!any) break;
    }
#pragma unroll
    for (int it = 0; it < 2; ++it) { float ssq = 0.f;
#pragma unroll
        for (int dd = 0; dd < 2; ++dd)
#pragma unroll
            for (int i = 0; i < 16; ++i) ssq += O[it][dd][i] * O[it][dd][i];
        ssq += shx(ssq, 32);
        if (h == 0) xs[(2 * hs + it) * 128 + 32 * (it ? 3 - p : p) + qi] = ssq; }
    __syncthreads();
#pragma unroll
    for (int it = 0; it < 2; ++it) { const int head = 2 * hs + it, rt = it ? 3 - p : p, qrow = 32 * rt + qi; const size_t token = tok0 + qrow;
        const float rstd = rsqrtf(((xs[qrow] + xs[128 + qrow]) + (xs[256 + qrow] + xs[384 + qrow])) * (1.0f / 256.0f) + NORM_EPS);
#pragma unroll
        for (int dd = 0; dd < 2; ++dd)
#pragma unroll
            for (int g = 0; g < 4; ++g) { const int col = head * 64 + 32 * dd + 8 * g + 4 * h; const f32x4 gg = *(const f32x4*)(gb + col);
                u32x2 w; w.x = pk2(O[it][dd][4 * g] * rstd * gg[0], O[it][dd][4 * g + 1] * rstd * gg[1]); w.y = pk2(O[it][dd][4 * g + 2] * rstd * gg[2], O[it][dd][4 * g + 3] * rstd * gg[3]);
                *(u32x2*)(MIXED + token * D_MODEL + 384 + col) = w; } }
}

DI void ret_kv_load(u32x4 (&v)[4][2], int u2, const bf16_t* PROJ, int tid) {
    const int hp = u2 % 3, n = (u2 / 3) & 63, b = u2 / 192;
    const size_t tok0 = (size_t)b * SEQ + (size_t)n * 128;
    const bf16_t* kp = PROJ + tok0 * PW + C_KC + (2 * hp) * 64; const bf16_t* vp = PROJ + tok0 * PW + C_VC + (2 * hp) * 64;
    const int r0 = tid >> 3, c = tid & 7;
#pragma unroll
    for (int i = 0; i < 2; ++i) { const size_t ro = (size_t)(r0 + 64 * i) * PW + c * 8;
        v[0][i] = *(const u32x4*)(kp + ro); v[1][i] = *(const u32x4*)(kp + 64 + ro); v[2][i] = *(const u32x4*)(vp + ro); v[3][i] = *(const u32x4*)(vp + 64 + ro); }
}
DI void ret_kv_unit(ldsp lds, int u2, const u32x4 (&v)[4][2], float* KV, int tid) {
    const int hp = u2 % 3, n = (u2 / 3) & 63, b = u2 / 192;
    ldsp KTs = lds, VTs = lds + 36864;
    {   const int r0 = tid >> 3, c = tid & 7;
#pragma unroll
        for (int t = 0; t < 4; ++t)
#pragma unroll
            for (int i = 0; i < 2; ++i) { u32x4 o = v[t][i];
                if (t < 2) { const float sc = exp2f((float)(127 - (r0 + 64 * i)) * lg2gamma(2 * hp + t));
                    o.x = pk2(__uint_as_float(o.x << 16) * sc, __uint_as_float(o.x & 0xffff0000u) * sc); o.y = pk2(__uint_as_float(o.y << 16) * sc, __uint_as_float(o.y & 0xffff0000u) * sc);
                    o.z = pk2(__uint_as_float(o.z << 16) * sc, __uint_as_float(o.z & 0xffff0000u) * sc); o.w = pk2(__uint_as_float(o.w << 16) * sc, __uint_as_float(o.w & 0xffff0000u) * sc); }
                *(LAS u32x4*)(lds + t * 18432 + (r0 + 64 * i) * 144 + c * 16) = o; } }
}
DI void ret_kv_compute(ldsp lds, int u2, float* KV, int tid) {
    const int hp = u2 % 3, n = (u2 / 3) & 63, b = u2 / 192;
    ldsp KTs = lds, VTs = lds + 36864;
    const int wave = __builtin_amdgcn_readfirstlane(tid >> 6), lane = tid & 63, hs = wave >> 2, eh = (wave >> 1) & 1, dh = wave & 1, r = lane & 31, h = lane >> 5;
    const int head = 2 * hp + hs;
    f32x16 acc = zero16();
    const int loff = vt_lane_off(lane);
#pragma unroll
    for (int s = 0; s < 8; ++s) acc = mfma32(vfrag_nat_tr(VTs + hs * 18432, loff, 32 * eh, 16 * s, h), vfrag_nat_tr(KTs + hs * 18432, loff, 32 * dh, 16 * s, h), acc);
    float* base = KV + ((size_t)(b * 6 + head) * 64 + n) * 4096;
#pragma unroll
    for (int i = 0; i < 16; ++i) base[(32 * eh + crow(i, h)) * 64 + 32 * dh + r] = acc[i];
}
DI void ret_scan_phase(float* KV, int tid, int bid) {
    typedef float f32x2s __attribute__((ext_vector_type(2)));
    const int total2 = BATCH * 6 * 2048;
    for (int idx = bid * NTHREADS + tid; idx < total2; idx += gridDim.x * NTHREADS) {
        const int bh = idx >> 11, ed = (idx & 2047) * 2, head = bh % 6; const float cd = exp2f(128.0f * lg2gamma(head));
        float* p = KV + (size_t)bh * 64 * 4096 + ed; f32x2s s = {0.f, 0.f};
#pragma unroll 32
        for (int n = 0; n < 64; ++n) { const f32x2s t = *(const f32x2s*)(p + (size_t)n * 4096); *(f32x2s*)(p + (size_t)n * 4096) = s; s = s * cd + t; }
    }
}
DI void ret_out_unit(ldsp lds, int u2, const bf16_t* PROJ, const float* KV, bf16_t* MIXED, const float* gcn, int tid, const float* toutc) {
    tid = launder(tid);
    const int hp = u2 % 3, n = (u2 / 3) & 63, b = u2 / 192;
    const size_t tok0 = (size_t)b * SEQ + (size_t)n * 128;
    ldsp Ks = lds, VTs = lds + 36864;
    __syncthreads();
    {   const int dsto[4] = {0, 18432, 36864, 36864 + 18432};
        const bf16_t* kp = PROJ + tok0 * PW + C_KC + (2 * hp) * 64; const bf16_t* vp = PROJ + tok0 * PW + C_VC + (2 * hp) * 64;
        const bf16_t* const srcs[4] = {kp, kp + 64, vp, vp + 64};
        const float lgs[4] = {0.f, 0.f, 0.f, 0.f};
        stage_tiles<4>(lds, dsto, srcs, lgs, tid); }
    __syncthreads();
    const int wave = __builtin_amdgcn_readfirstlane(tid >> 6), lane = tid & 63, hs = wave >> 2, rt = wave & 3, qi = lane & 31, h = lane >> 5;
    const int head = 2 * hp + hs, qrow = 32 * rt + qi; const size_t token = tok0 + qrow;
    ldsp Kh = Ks + hs * 18432, Vh = VTs + hs * 18432; const int loff = vt_lane_off(lane);
    const float lg = lg2gamma(head);
    bf16x8 q[4];
#pragma unroll
    for (int kk = 0; kk < 4; ++kk) q[kk] = *(const bf16x8*)(PROJ + token * PW + C_QC + head * 64 + 16 * kk + 8 * h);
    f32x16 cross[2], intra[2];
    const float* ST = KV + ((size_t)(b * 6 + head) * 64 + n) * 4096;
#pragma unroll
    for (int eh = 0; eh < 2; ++eh) { cross[eh] = zero16(); intra[eh] = zero16();
#pragma unroll
        for (int kk = 0; kk < 4; ++kk) { const float* p = ST + (32 * eh + qi) * 64 + 16 * kk + 8 * h; const f32x4 a0 = *(const f32x4*)p, a1 = *(const f32x4*)(p + 4);
            u32x4 pa; pa.x = pk2(a0[0], a0[1]); pa.y = pk2(a0[2], a0[3]); pa.z = pk2(a1[0], a1[1]); pa.w = pk2(a1[2], a1[3]);
            cross[eh] = mfma32(__builtin_bit_cast(bf16x8, pa), q[kk], cross[eh]); } }
    for (int kt = 0; kt <= rt; ++kt) {
        f32x16 s = zero16();
#pragma unroll
        for (int kk = 0; kk < 4; ++kk) s = mfma32(kfrag(Kh, 32 * kt + qi, kk, h), q[kk], s);
        const int dbase = launder(qrow - 32 * kt - 4 * h);
#pragma unroll
        for (int i = 0; i < 16; ++i) { const int dlt = dbase - ((i & 3) + 8 * (i >> 2)); s[i] = dlt >= 0 ? s[i] * exp2f((float)dlt * lg) : 0.f; }
#pragma unroll
        for (int s2 = 0; s2 < 2; ++s2) { const bf16x8 Pk = pack8(s, s2);
#pragma unroll
            for (int dd = 0; dd < 2; ++dd) intra[dd] = mfma32(vfrag_perm_tr(Vh, loff, 32 * dd, 32 * kt + 16 * s2, h), Pk, intra[dd]); }
    }
    const float qdec = exp2f((float)(qrow + 1) * lg);
    float sum = 0.f;
#pragma unroll
    for (int dd = 0; dd < 2; ++dd)
#pragma unroll
        for (int i = 0; i < 16; ++i) { const float o = intra[dd][i] + qdec * cross[dd][i]; intra[dd][i] = o; sum += o; }
    sum += shx(sum, 32);
    const float mu = sum * (1.0f / 64.0f); float var = 0.f;
#pragma unroll
    for (int dd = 0; dd < 2; ++dd)
#pragma unroll
        for (int i = 0; i < 16; ++i) { const float d = intra[dd][i] - mu; intra[dd][i] = d; var += d * d; }
    var += shx(var, 32);
    const float rs = rsqrtf(var * (1.0f / 64.0f) + NORM_EPS);
#pragma unroll
    for (int dd = 0; dd < 2; ++dd)
#pragma unroll
        for (int g = 0; g < 4; ++g) { const int col = head * 64 + 32 * dd + 8 * g + 4 * h; const f32x4 gg = *(const f32x4*)(gcn + col);
            const u32x2 gt = *(const u32x2*)(PROJ + token * PW + C_GC + col);
            const float g0 = bf2f((unsigned short)(gt.x & 0xffffu)), g1 = bf2f((unsigned short)(gt.x >> 16)), g2 = bf2f((unsigned short)(gt.y & 0xffffu)), g3 = bf2f((unsigned short)(gt.y >> 16));
            const float o0 = intra[dd][4 * g] * rs * gg[0] * (g0 / (1.0f + __expf(-g0))), o1 = intra[dd][4 * g + 1] * rs * gg[1] * (g1 / (1.0f + __expf(-g1)));
            const float o2 = intra[dd][4 * g + 2] * rs * gg[2] * (g2 / (1.0f + __expf(-g2))), o3 = intra[dd][4 * g + 3] * rs * gg[3] * (g3 / (1.0f + __expf(-g3)));
            u32x2 w; w.x = pk2(o0, o1); w.y = pk2(o2, o3);
            if (n == 0 && qrow == 0) { const f32x4 ex = *(const f32x4*)(toutc + b * 384 + col); w.x = pk2(ex[0], ex[1]); w.y = pk2(ex[2], ex[3]); }
            *(u32x2*)(MIXED + token * D_MODEL + 640 + col) = w; }
}

constexpr size_t WS_T0 = 103 * MiB;
constexpr int T0_XM = 16384, T0_PROJ = 24576, T0_Y1 = 49152, T0_Y2 = 57344, T0_HT = 65536, T0_OUTC = 98304;
template <int KN> DI float t0_gemv16(const float* W, int N, int n0, const float* inT, ldsp redb, int tid) {
    const int cl = tid & 3, ks = tid >> 2;
    float acc[8][4];
#pragma unroll
    for (int r = 0; r < 8; ++r)
#pragma unroll
        for (int c = 0; c < 4; ++c) acc[r][c] = 0.f;
    const float* wp = W + (size_t)(ks * KN) * N + n0 + 4 * cl; const float* ip = inT + (size_t)(ks * KN) * 8;
#pragma unroll
    for (int k0 = 0; k0 < KN; k0 += 8) {
        f32x4 w[8];
#pragma unroll
        for (int k = 0; k < 8; ++k) w[k] = *(const f32x4*)(wp + (size_t)(k0 + k) * N);
#pragma unroll
        for (int k = 0; k < 8; ++k) { const f32x4 i0 = *(const f32x4*)(ip + (k0 + k) * 8), i1 = *(const f32x4*)(ip + (k0 + k) * 8 + 4);
#pragma unroll
            for (int r = 0; r < 4; ++r)
#pragma unroll
                for (int c = 0; c < 4; ++c) { acc[r][c] += i0[r] * w[k][c]; acc[4 + r][c] += i1[r] * w[k][c]; } } }
    LAS float* red = (LAS float*)redb;
#pragma unroll
    for (int r = 0; r < 8; ++r) *(LAS f32x4*)(red + (ks * 4 + cl) * 32 + r * 4) = (f32x4){acc[r][0], acc[r][1], acc[r][2], acc[r][3]};
    __syncthreads();
    float s = 0.f;
    if (tid < 128) { const int r = tid >> 4, c = tid & 15;
#pragma unroll 16
        for (int j = 0; j < 128; ++j) s += red[(j * 4 + (c >> 2)) * 32 + r * 4 + (c & 3)]; }
    __syncthreads();
    return s;
}
DI void t0_load_row(const float* p, int lane, f32x4 (&x)[4]) {
#pragma unroll
    for (int j = 0; j < 4; ++j) x[j] = *((const f32x4*)p + lane + 64 * j); }
DI float t0_ssq(const f32x4 (&x)[4]) { float s = 0.f;
#pragma unroll
    for (int j = 0; j < 4; ++j) s += (x[j][0] * x[j][0] + x[j][1] * x[j][1]) + (x[j][2] * x[j][2] + x[j][3] * x[j][3]);
    return wave_sum(s); }
DI void t0_put_inT(LAS float* inT, const f32x4 (&x)[4], const float* g, int lane, int r) {
#pragma unroll
    for (int j = 0; j < 4; ++j) { const f32x4 gg = *((const f32x4*)g + lane + 64 * j);
#pragma unroll
        for (int e = 0; e < 4; ++e) inT[(lane * 4 + 256 * j + e) * 8 + r] = x[j][e] * gg[e]; } }
DI void t0_store_row(float* p, int lane, const f32x4 (&x)[4]) {
#pragma unroll
    for (int j = 0; j < 4; ++j) *((f32x4*)p + lane + 64 * j) = x[j]; }
DI void t0_stage1(unsigned char* ldsg, unsigned char* ws, int l, int tb, const float* xin, const float* w_in_l, const float* g_post_prev, const float* g_pre, int tid) {
    tid = launder(tid);
    float* T = (float*)(ws + WS_T0); const int r = tid >> 6, lane = tid & 63;
    LAS float* inT = (LAS float*)(ldsp)ldsg; LAS float* rs = (LAS float*)((ldsp)ldsg + 98304);
    f32x4 x[4];
    if (l == 0) t0_load_row(xin + (size_t)r * SEQ * D_MODEL, lane, x);
    else { f32x4 y[4]; t0_load_row(T + T0_XM + r * 1024, lane, x); t0_load_row(T + T0_Y2 + r * 1024, lane, y);
        const float rstd = rsqrtf(t0_ssq(y) * (1.0f / D_MODEL) + NORM_EPS);
#pragma unroll
        for (int j = 0; j < 4; ++j) x[j] = x[j] + y[j] * rstd * *((const f32x4*)g_post_prev + lane + 64 * j); }
    const float rstdx = rsqrtf(t0_ssq(x) * (1.0f / D_MODEL) + NORM_EPS);
    if (lane == 0) rs[r] = rstdx;
    t0_put_inT(inT, x, g_pre, lane, r);
    if (tb == 0) t0_store_row(T + (l & 1) * 8192 + r * 1024, lane, x);
    __syncthreads();
    const float s = t0_gemv16<8>(w_in_l, IN_W, 16 * tb, (const float*)ldsg, (ldsp)ldsg + 32768, tid);
    if (tid < 128) T[T0_PROJ + (tid >> 4) * 3072 + 16 * tb + (tid & 15)] = s * rs[tid >> 4];
    __syncthreads();
}
DI void t0_stage2(unsigned char* ldsg, unsigned char* ws, int l, int tb, const float* w_out_l, const float* sinks_l, const float* bg, const float* rope_c, const float* rope_s, int tid) {
    tid = launder(tid);
    float* T = (float*)(ws + WS_T0); const int r = tid >> 6, lane = tid & 63;
    LAS float* inT = (LAS float*)(ldsp)ldsg; const float* P = T + T0_PROJ + r * 3072;
    const float cc = rope_c[lane & 31], ss = rope_s[lane & 31];
#define T0_ROPE(v, dst) { const float v_ = (v), o_ = shx(v_, 32); dst = (lane < 32) ? (v_ * cc - o_ * ss) : (o_ * ss + v_ * cc); }
    float outa[6]; float ssqA = 0.f;
#pragma unroll
    for (int kv = 0; kv < 2; ++kv) { float ka; T0_ROPE(P[C_KA + kv * 64 + lane], ka); const float va = P[C_VA + kv * 64 + lane];
#pragma unroll
        for (int g = 0; g < 3; ++g) { const int h = 3 * kv + g; float qa; T0_ROPE(P[C_QA + h * 64 + lane], qa);
            const float sc = wave_sum(qa * ka) * 0.125f, sink = sinks_l[h], mx = fmaxf(sc, sink), e1 = expf(sc - mx), e2 = expf(sink - mx);
            outa[h] = (e1 / (e1 + e2)) * va; ssqA += outa[h] * outa[h]; } }
    const float rstdA = rsqrtf(wave_sum(ssqA) * (1.0f / 384.0f) + NORM_EPS);
#pragma unroll
    for (int h = 0; h < 6; ++h) inT[(h * 64 + lane) * 8 + r] = outa[h] * rstdA * bg[h * 64 + lane];
#pragma unroll
    for (int h = 0; h < 4; ++h) inT[(384 + h * 64 + lane) * 8 + r] = 0.f;
#pragma unroll
    for (int h = 0; h < 6; ++h) { float qc, kc; T0_ROPE(P[C_QC + h * 64 + lane], qc); T0_ROPE(P[C_KC + h * 64 + lane], kc);
        const float c = wave_sum(qc * kc) * 0.125f, o = c * P[C_VC + h * 64 + lane], mu = wave_sum(o) * (1.0f / 64.0f), d = o - mu, var = wave_sum(d * d) * (1.0f / 64.0f);
        const float gt = P[C_GC + h * 64 + lane], oc = d * rsqrtf(var + NORM_EPS) * bg[640 + h * 64 + lane] * (gt / (1.0f + expf(-gt)));
        inT[(640 + h * 64 + lane) * 8 + r] = oc;
        if (tb == 0) T[T0_OUTC + r * 384 + h * 64 + lane] = oc; }
#undef T0_ROPE
    __syncthreads();
    const float s = t0_gemv16<8>(w_out_l, D_MODEL, 16 * tb, (const float*)ldsg, (ldsp)ldsg + 32768, tid);
    if (tid < 128) T[T0_Y1 + (tid >> 4) * 1024 + 16 * tb + (tid & 15)] = s;
    __syncthreads();
}
DI void t0_stage3(unsigned char* ldsg, unsigned char* ws, int l, int tb, const float* w_up_l, const float* g_post, const float* g_pre, int tid) {
    tid = launder(tid);
    float* T = (float*)(ws + WS_T0); const int r = tid >> 6, lane = tid & 63;
    LAS float* inT = (LAS float*)(ldsp)ldsg; LAS float* rs = (LAS float*)((ldsp)ldsg + 98304);
    f32x4 x[4], y[4]; t0_load_row(T + (l & 1) * 8192 + r * 1024, lane, x); t0_load_row(T + T0_Y1 + r * 1024, lane, y);
    const float rstd = rsqrtf(t0_ssq(y) * (1.0f / D_MODEL) + NORM_EPS);
#pragma unroll
    for (int j = 0; j < 4; ++j) x[j] = x[j] + y[j] * rstd * *((const f32x4*)g_post + lane + 64 * j);
    const float rstdx = rsqrtf(t0_ssq(x) * (1.0f / D_MODEL) + NORM_EPS);
    if (lane == 0) rs[r] = rstdx;
    t0_put_inT(inT, x, g_pre, lane, r);
    if (tb == 0) t0_store_row(T + T0_XM + r * 1024, lane, x);
    __syncthreads();
    const float s = t0_gemv16<8>(w_up_l, D_FF, 16 * tb, (const float*)ldsg, (ldsp)ldsg + 32768, tid);
    if (tid < 128) { const float v = fmaxf(s * rs[tid >> 4], 0.f); T[T0_HT + (16 * tb + (tid & 15)) * 8 + (tid >> 4)] = v * v; }
    __syncthreads();
}
DI void t0_stage4(unsigned char* ldsg, unsigned char* ws, int tb, const float* w_down_l, int tid) {
    tid = launder(tid);
    float* T = (float*)(ws + WS_T0);
    const float s = t0_gemv16<32>(w_down_l, D_MODEL, 16 * tb, T + T0_HT, (ldsp)ldsg + 32768, tid);
    if (tid < 128) T[T0_Y2 + (tid >> 4) * 1024 + 16 * tb + (tid & 15)] = s;
    __syncthreads();
}

DI f32x4 unpk4(u32x2 w) { f32x4 r; r[0] = __uint_as_float(w.x << 16); r[1] = __uint_as_float(w.x & 0xffff0000u); r[2] = __uint_as_float(w.y << 16); r[3] = __uint_as_float(w.y & 0xffff0000u); return r; }
template <bool SRC_BF, bool DST_BF>
DI void norm_res_phase(const void* xsrc_, const bf16_t* Y, const float* gpost, const float* gpre, void* xout_, bf16_t* XN, int tid, int bid) {
    constexpr int NR = 4;
    const int wave = tid >> 6, lane = tid & 63, NW = gridDim.x * NWAVES;
    for (int row0 = bid * NWAVES + wave; row0 < M_TOK; row0 += NR * NW) {
        f32x4 xf[SRC_BF ? 1 : NR][4]; u32x2 xraw[SRC_BF ? NR : 1][4]; u32x2 yraw[NR][4];
#pragma unroll
        for (int r = 0; r < NR; ++r) { const size_t row = (size_t)row0 + (size_t)r * NW;
            if (SRC_BF) { const u32x2* xr = (const u32x2*)((const bf16_t*)xsrc_ + row * D_MODEL) + lane;
#pragma unroll
                for (int j = 0; j < 4; ++j) xraw[SRC_BF ? r : 0][j] = xr[64 * j];
            } else { const f32x4* xr = (const f32x4*)((const float*)xsrc_ + row * D_MODEL) + lane;
#pragma unroll
                for (int j = 0; j < 4; ++j) xf[SRC_BF ? 0 : r][j] = xr[64 * j]; }
            if (Y) { const u32x2* yr = (const u32x2*)(Y + row * D_MODEL) + lane;
#pragma unroll
                for (int j = 0; j < 4; ++j) yraw[r][j] = yr[64 * j]; } }
        f32x4 gp[4], gq[4];
        if (Y) {
#pragma unroll
            for (int j = 0; j < 4; ++j) gp[j] = *((const f32x4*)gpost + lane + 64 * j); }
        if (XN) {
#pragma unroll
            for (int j = 0; j < 4; ++j) gq[j] = *((const f32x4*)gpre + lane + 64 * j); }
#pragma unroll
        for (int r = 0; r < NR; ++r) { const size_t row = (size_t)row0 + (size_t)r * NW;
            f32x4 v[4];
#pragma unroll
            for (int j = 0; j < 4; ++j) v[j] = SRC_BF ? unpk4(xraw[SRC_BF ? r : 0][j]) : xf[SRC_BF ? 0 : r][j];
            if (Y) { f32x4 y[4]; float s = 0.f;
#pragma unroll
                for (int j = 0; j < 4; ++j) { y[j] = unpk4(yraw[r][j]); s += (y[j][0] * y[j][0] + y[j][1] * y[j][1]) + (y[j][2] * y[j][2] + y[j][3] * y[j][3]); }
                const float rstd = rsqrtf(wave_sum(s) * (1.0f / D_MODEL) + NORM_EPS);
#pragma unroll
                for (int j = 0; j < 4; ++j) v[j] = v[j] + y[j] * rstd * gp[j]; }
            if (xout_) {
                if (DST_BF) { u32x2* xo = (u32x2*)((bf16_t*)xout_ + row * D_MODEL) + lane;
#pragma unroll
                    for (int j = 0; j < 4; ++j) { u32x2 w; w.x = pk2(v[j][0], v[j][1]); w.y = pk2(v[j][2], v[j][3]); xo[64 * j] = w;
                        v[j] = unpk4(w); }
                } else { f32x4* xo = (f32x4*)((float*)xout_ + row * D_MODEL) + lane;
#pragma unroll
                    for (int j = 0; j < 4; ++j) xo[64 * j] = v[j]; } }
            if (XN) { float s = 0.f;
#pragma unroll
                for (int j = 0; j < 4; ++j) s += (v[j][0] * v[j][0] + v[j][1] * v[j][1]) + (v[j][2] * v[j][2] + v[j][3] * v[j][3]);
                const float rstd = rsqrtf(wave_sum(s) * (1.0f / D_MODEL) + NORM_EPS);
                u32x2* xo = (u32x2*)(XN + row * D_MODEL) + lane;
#pragma unroll
                for (int j = 0; j < 4; ++j) { const f32x4 o = v[j] * rstd * gq[j]; u32x2 w; w.x = pk2(o[0], o[1]); w.y = pk2(o[2], o[3]); xo[64 * j] = w; } }
        }
    }
}
template <int MODE> DI void transpose_item(const float* W, int K, int Nsrc, int Ndst, bf16_t* WT, LAS float* scr, int item, int lane, const float* gk) {
    const int nblk = Ndst / 32, kb = item / nblk, nbk = item % nblk, k0 = 64 * kb, n0 = 32 * nbk;
    const int nd = n0 + (lane & 31); int src = nd; float sc = 1.f; bool ok = true;
    if (MODE == 1) { const int head = nd >> 6, p = nd & 63; const bool rope = (head < 8) || (head >= 22 && head < 34);
        const int f = rope ? (4 * (p >> 3) + (p & 3) + 32 * ((p >> 2) & 1)) : p; ok = nd < IN_W; src = ok ? head * 64 + f : 0;
        sc = ((head < 6) || (head >= 10 && head < 14) || (head >= 28 && head < 34)) ? 0.125f : 1.f; }
#pragma unroll
    for (int i = 0; i < 32; ++i) { const int kk = 2 * i + (lane >> 5); scr[kk * 33 + (lane & 31)] = ok ? W[(size_t)(k0 + kk) * Nsrc + src] * (gk ? sc * gk[k0 + kk] : sc) : 0.f; }
    LDS_WAIT();
    const int c = lane & 7;
#pragma unroll
    for (int j = 0; j < 4; ++j) { const int n = (lane >> 3) + 8 * j; const LAS float* s = scr + (8 * c) * 33 + n;
        u32x4 o; o.x = pk2(s[0 * 33], s[1 * 33]); o.y = pk2(s[2 * 33], s[3 * 33]); o.z = pk2(s[4 * 33], s[5 * 33]); o.w = pk2(s[6 * 33], s[7 * 33]);
        *(u32x4*)(WT + (size_t)(n0 + n) * K + k0 + 8 * c) = o; }
    LDS_WAIT();
}

#ifdef DUP_MIX
#define MIXREP 2
#else
#define MIXREP 1
#endif
#ifdef DUP_P2
#define MIXREP2 2
#else
#define MIXREP2 MIXREP
#endif
struct Args { const float* x; const int* positions; const float* w_in; const float* w_out; const float* sinks; const float* branch_gain; const float* w_up; const float* w_down;
              const float* g_mix_pre; const float* g_mix_post; const float* g_mlp_pre; const float* g_mlp_post; float* out; unsigned char* ws; int ph_lo, ph_hi; };

__global__ void __launch_bounds__(NTHREADS, 2) fwd_kernel(Args a) {
    extern __shared__ __attribute__((aligned(16))) unsigned char lds_raw[];
    ldsp lds = (ldsp)lds_raw;
    cg::grid_group grid = cg::this_grid();
    const int G = gridDim.x;
    unsigned char* ws = a.ws;
    float* ROPE_C = (float*)(ws + WS_ROPE); float* ROPE_S = ROPE_C + SEQ * 32;
    bf16_t* XN = (bf16_t*)(ws + WS_XN); bf16_t* Y = (bf16_t*)(ws + WS_Y); bf16_t* PROJ = (bf16_t*)(ws + WS_PROJ); bf16_t* MIXED = (bf16_t*)(ws + WS_MIXED); bf16_t* H = (bf16_t*)(ws + WS_H); bf16_t* XB = (bf16_t*)(ws + WS_XB); float* PS1 = (float*)(ws + WS_PS1); float* PS2 = (float*)(ws + WS_PS2); unsigned* CNT = (unsigned*)(ws + WS_CNT);
    float* KV = (float*)(ws + WS_KV);
    volatile LAS unsigned* MISC = (volatile LAS unsigned*)(lds + 155392);
    if (threadIdx.x < 16) MISC[threadIdx.x] = 0u;
    __syncthreads();
    const XcdBarrier xbar = xcd_barrier_post((unsigned*)ws + 4096, MISC + 8);
    const int lo = a.ph_lo, hi = a.ph_hi;
    for (int ph = lo; ph < hi; ++ph) {
        int tid_l = threadIdx.x, bid_l = blockIdx.x; asm volatile("" : "+v"(tid_l)); asm volatile("" : "+s"(bid_l));
        const int tid = tid_l, bid = bid_l, wave = __builtin_amdgcn_readfirstlane(tid >> 6), lane = tid & 63;
        if (ph == 0) {
#ifdef DUP_P0
            for (int rep0_ = 0; rep0_ < 2; ++rep0_) {
#endif
            for (int idx = bid * NTHREADS + tid; idx < SEQ * 32; idx += G * NTHREADS) { const int s = idx >> 5, i = idx & 31;
                const float inv = powf(10000.0f, -(float)(2 * i) / 64.0f), ang = (float)a.positions[s] * inv; ROPE_C[idx] = cosf(ang); ROPE_S[idx] = sinf(ang); }
            LAS float* scr = (LAS float*)(lds + wave * 16384);
            constexpr int I_IN = 16 * 96, I_OUT = 16 * 32, I_UP = 16 * 128, I_DN = 64 * 32, I_L = I_IN + I_OUT + I_UP + I_DN;
            for (int it = bid * NWAVES + wave; it < DEPTH * I_L; it += G * NWAVES) {
                const int l = it / I_L; int r = it % I_L; unsigned char* wl = ws + WS_W + (size_t)l * W_LAYER;
                if (r < I_IN) { transpose_item<1>(a.w_in + (size_t)l * D_MODEL * IN_W, D_MODEL, IN_W, PW, (bf16_t*)wl, scr, r, lane, a.g_mix_pre + l * D_MODEL); continue; } r -= I_IN;
                if (r < I_OUT) { transpose_item<0>(a.w_out + (size_t)l * D_MODEL * D_MODEL, D_MODEL, D_MODEL, D_MODEL, (bf16_t*)(wl + W_OUT_OFF), scr, r, lane, nullptr); continue; } r -= I_OUT;
                if (r < I_UP) { transpose_item<0>(a.w_up + (size_t)l * D_MODEL * D_FF, D_MODEL, D_FF, D_FF, (bf16_t*)(wl + W_UP_OFF), scr, r, lane, a.g_mlp_pre + l * D_MODEL); continue; } r -= I_UP;
                transpose_item<0>(a.w_down + (size_t)l * D_FF * D_MODEL, D_FF, D_MODEL, D_MODEL, (bf16_t*)(wl + W_DOWN_OFF), scr, r, lane, nullptr);
            }
            for (int idx = bid * NTHREADS + tid; idx < DEPTH * 4 * D_MODEL; idx += G * NTHREADS) { const int l = idx >> 12, w = (idx >> 10) & 3, c = idx & 1023;
                const float* srcg = (w == 0) ? a.g_mix_pre : (w == 1) ? a.g_mix_post : (w == 2) ? a.g_mlp_pre : a.g_mlp_post; ((float*)(ws + WS_GAIN))[idx] = srcg[l * D_MODEL + c]; }
            for (int row0 = bid * NWAVES + wave; row0 < M_TOK; row0 += 4 * G * NWAVES) {
                f32x4 v[4][4];
#pragma unroll
                for (int r = 0; r < 4; ++r) { const f32x4* xr = (const f32x4*)(a.x + ((size_t)row0 + (size_t)r * G * NWAVES) * D_MODEL) + lane;
#pragma unroll
                    for (int j = 0; j < 4; ++j) v[r][j] = xr[64 * j]; }
#pragma unroll
                for (int r = 0; r < 4; ++r) { const size_t row = (size_t)row0 + (size_t)r * G * NWAVES; float s = 0.f;
#pragma unroll
                    for (int j = 0; j < 4; ++j) s += (v[r][j][0] * v[r][j][0] + v[r][j][1] * v[r][j][1]) + (v[r][j][2] * v[r][j][2] + v[r][j][3] * v[r][j][3]);
#pragma unroll
                    for (int j = 0; j < 4; ++j) { u32x2 wb; wb.x = pk2(v[r][j][0], v[r][j][1]); wb.y = pk2(v[r][j][2], v[r][j][3]); ((u32x2*)(XB + row * D_MODEL) + lane)[64 * j] = wb; }
                    s = wave_sum(s);
                    if (lane == 0) *(f32x4*)(PS2 + row * 4) = (f32x4){s, 0.f, 0.f, 0.f}; }
            }
            __syncthreads();
#ifdef DUP_P0
            }
#endif
        } else {
            const int l = (ph - 1) / 7, k = (ph - 1) % 7;
            unsigned char* wl = ws + WS_W + (size_t)l * W_LAYER;
            const float* bg = a.branch_gain + l * D_MODEL;
            if (k == 0 && bid < 184) t0_stage1(lds_raw, ws, l, bid, a.x, a.w_in + (size_t)l * D_MODEL * IN_W, a.g_mlp_post + (l > 0 ? l - 1 : 0) * D_MODEL, a.g_mix_pre + l * D_MODEL, tid);
            if (k == 1 && bid >= 192) t0_stage2(lds_raw, ws, l, bid - 192, a.w_out + (size_t)l * D_MODEL * D_MODEL, a.sinks + l * 6, bg, ROPE_C, ROPE_S, tid);
            if (k == 2) t0_stage3(lds_raw, ws, l, bid, a.w_up + (size_t)l * D_MODEL * D_FF, a.g_mix_post + l * D_MODEL, a.g_mlp_pre + l * D_MODEL, tid);
            if (k == 3 && bid < 64) t0_stage4(lds_raw, ws, bid, a.w_down + (size_t)l * D_FF * D_MODEL, tid);
            if (k == 0 || k >= 4) {
                const bf16_t* A = XB; const bf16_t* Bt = (const bf16_t*)wl; int N = PW, K = D_MODEL;
                int mode = 2;
                if (k == 4) { A = MIXED; Bt = (const bf16_t*)(wl + W_OUT_OFF); N = D_MODEL; mode = 3; }
                if (k == 5) { Bt = (const bf16_t*)(wl + W_UP_OFF); N = D_FF; mode = 1; }
                if (k == 6) { A = H; Bt = (const bf16_t*)(wl + W_DOWN_OFF); N = D_MODEL; K = D_FF; mode = 4; }
                pg8::EpiAny E{ws, a.x, a.out, mode, l};
                pg8::Gemm g{A, Bt, M_TOK, N, K}; pg8::StaticOrder S; S.init(M_TOK, N, G, bid);
                pg8::gemm_phase<pg8::EpiAny, pg8::StaticOrder, PG8_ALIGN, PG8_SP2>(lds, g, S, E, tid);
            } else if (k == 1) {
                int u_ = (G == 256) ? ((bid & 7) * 32 + (bid >> 3)) : bid;
                for (; u_ < 512; u_ += G) swa_unit(lds, u_, PROJ, MIXED, a.sinks + l * 6, bg, tid);
                {
                    const int tl = launder(tid);
                    u32x4 pre[4][2];
#pragma unroll
                    for (int t_ = 0; t_ < 4; ++t_) { pre[t_][0] = (u32x4){0u, 0u, 0u, 0u}; pre[t_][1] = (u32x4){0u, 0u, 0u, 0u}; }
                    if (u_ < 2048) ret_kv_load(pre, u_ - 512, PROJ, tl);
                    for (; u_ < 2048; u_ += G) {
                        __syncthreads();
                        ret_kv_unit(lds, u_ - 512, pre, KV, tl);
                        __syncthreads();
                        if (u_ + G < 2048) ret_kv_load(pre, u_ + G - 512, PROJ, tl);
                        ret_kv_compute(lds, u_ - 512, KV, tl);
                    }
                }
                __syncthreads();
            } else if (k == 2) {
                ret_scan_phase(KV, tid, bid);
            } else {
                for (int u_ = (G == 256) ? ((bid & 7) * 32 + (bid >> 3)) : bid; u_ < 2048; u_ += G) { const int u = u_;
                    if (u < 512) sb_unit(lds, u, PROJ, MIXED, bg + 384, tid);
                    else ret_out_unit(lds, u - 512, PROJ, KV, MIXED, bg + 640, tid, (const float*)(ws + WS_T0) + T0_OUTC);
                }
                __syncthreads();
            }
        }
        if (ph + 1 < hi) { if (ph == lo) grid.sync(); else xcd_barrier(xbar); }
    }
}

extern "C" void kernel_launch(void* const* d_in, const int* in_sizes, int n_in, void* d_out, int out_size, void* d_ws, size_t ws_size, hipStream_t stream) {
    static int grid = 0;
    if (grid == 0) {
        if (n_in != 12 || in_sizes[0] != M_TOK * D_MODEL || out_size != M_TOK * D_MODEL || ws_size < WS_END) { fprintf(stderr, "kernel_launch: unexpected shapes (n_in %d in0 %d out %d ws %zu)\n", n_in, n_in > 0 ? in_sizes[0] : -1, out_size, ws_size); grid = -1; return; }
        int dev = 0, cus = 0, per_cu = 0;
        if (hipGetDevice(&dev) != hipSuccess || hipDeviceGetAttribute(&cus, hipDeviceAttributeMultiprocessorCount, dev) != hipSuccess) { grid = -1; return; }
        if (hipFuncSetAttribute((const void*)fwd_kernel, hipFuncAttributeMaxDynamicSharedMemorySize, LDS_BYTES) != hipSuccess) { fprintf(stderr, "kernel_launch: hipFuncSetAttribute failed\n"); grid = -1; return; }
        if (hipOccupancyMaxActiveBlocksPerMultiprocessor(&per_cu, (const void*)fwd_kernel, NTHREADS, LDS_BYTES) != hipSuccess || per_cu < 1) fprintf(stderr, "kernel_launch: occupancy query reports %d\n", per_cu);
        (void)hipGetLastError();
        grid = cus;
    }
    if (grid < 0) return;
    if (hipMemsetAsync(d_ws, 0, 262144, stream) != hipSuccess) { fprintf(stderr, "kernel_launch: memset of the barrier words failed\n"); return; }
    Args a{};
    a.x = (const float*)d_in[0]; a.positions = (const int*)d_in[1]; a.w_in = (const float*)d_in[2]; a.w_out = (const float*)d_in[3]; a.sinks = (const float*)d_in[4]; a.branch_gain = (const float*)d_in[5];
    a.w_up = (const float*)d_in[6]; a.w_down = (const float*)d_in[7]; a.g_mix_pre = (const float*)d_in[8]; a.g_mix_post = (const float*)d_in[9]; a.g_mlp_pre = (const float*)d_in[10]; a.g_mlp_post = (const float*)d_in[11];
    a.out = (float*)d_out; a.ws = (unsigned char*)d_ws; a.ph_lo = 0; a.ph_hi = 1 + 7 * DEPTH;
    void* args[] = {&a};
    hipError_t e = hipLaunchCooperativeKernel((const void*)fwd_kernel, dim3(grid), dim3(NTHREADS), args, LDS_BYTES, stream);
    if (e != hipSuccess) fprintf(stderr, "kernel_launch: cooperative launch failed: %s (grid %d)\n", hipGetErrorString(e), grid);
}
```

```cpp
#include <hip/hip_runtime.h>
#include <hip/hip_cooperative_groups.h>
#include <cstdio>
#include <cstdint>
namespace cg = cooperative_groups;
#define PG8_SP2 true
#define PG8_ALIGN true
constexpr int D_MODEL = 1024, BATCH = 8, SEQ = 8192, DEPTH = 4, M_TOK = BATCH * SEQ, D_FF = 4096;
constexpr int IN_W = 2944, PW = 3072;
constexpr int C_QA = 0, C_KA = 384, C_VA = 512, C_QB = 640, C_KB = 896, C_VB = 1152, C_QC = 1408, C_KC = 1792, C_VC = 2176, C_GC = 2560;
constexpr float NORM_EPS = 1e-6f;
constexpr float SB_THR = -36.0f;
constexpr int NWAVES = 8, NTHREADS = 512;
constexpr int LDS_BYTES = 155648;
constexpr size_t MiB = 1u << 20;
constexpr size_t WS_ROPE = 1 * MiB;
constexpr size_t WS_W = 4 * MiB;
constexpr size_t W_LAYER = 24 * MiB, W_OUT_OFF = 6 * MiB, W_UP_OFF = 8 * MiB, W_DOWN_OFF = 16 * MiB;
constexpr size_t WS_CNT = 65536;
constexpr size_t WS_PS1 = 100 * MiB;
constexpr size_t WS_PS2 = 101 * MiB;
constexpr size_t WS_GAIN = 102 * MiB;
constexpr size_t WS_XN = 104 * MiB;
constexpr size_t WS_MIXED = 232 * MiB;
constexpr size_t WS_Y = 232 * MiB;
constexpr size_t WS_H = 360 * MiB;
constexpr size_t WS_PROJ = 360 * MiB;
constexpr size_t WS_KV = 744 * MiB;
constexpr size_t WS_XB = 872 * MiB;
constexpr size_t WS_END = 1000 * MiB;

__device__ __forceinline__ float shx(float v, int msk) { int l = __builtin_amdgcn_mbcnt_hi(~0u, __builtin_amdgcn_mbcnt_lo(~0u, 0u)); asm volatile("" : "+v"(l)); return __int_as_float(__builtin_amdgcn_ds_bpermute((l ^ msk) << 2, __float_as_int(v))); }
namespace pg8 {
#define PG8_LAS __attribute__((address_space(3)))
typedef unsigned short bf16_t;
typedef short bf16x8 __attribute__((ext_vector_type(8)));
typedef float f32x4 __attribute__((ext_vector_type(4)));
typedef unsigned u32x4 __attribute__((ext_vector_type(4)));
constexpr int BM = 256, BK = 64, HALF = 128, HTB = HALF * BK * 2  , STAGE_BYTES = 8 * HTB, NXCD = 8, WGM = 8;

__host__ __device__ __forceinline__ int lds_byte(int r, int c) { const int st = (r >> 4) * 2 + (c >> 5), rr = r & 15, cc = c & 31, ob = rr * 64 + cc * 2; return st * 1024 + (ob ^ (((ob >> 9) & 1) << 5)); }
__host__ __device__ __forceinline__ void stage_rc(int b, int& R, int& C) { const int st = b / 1024, sb = b % 1024, swz = sb ^ (((sb >> 9) & 1) << 5); R = (st >> 1) * 16 + swz / 64; C = (st & 1) * 32 + (swz % 64) / 2; }
__host__ __device__ __forceinline__ int perm32(int rho) { const int n = rho >> 4, i = rho & 15; return 8 * (i >> 2) + 4 * n + (i & 3); }

struct Unit { int pm, pn; };
struct Gemm { const bf16_t* A; const bf16_t* Bt; int M, N, K; };

struct StaticOrder {
    int nM, nN, nwg, G, c;
    __host__ __device__ void init(int M, int N, int G_, int c_) { nM = M / BM; nN = N / BM; nwg = nM * nN; G = G_; c = c_; }
    __host__ __device__ bool next(int i, Unit& u) const {
        const long L = (long)i * G + c; if (L >= nwg) return false;
        int wgid = (int)L; { const int q = nwg / NXCD, r = nwg % NXCD, xcd = wgid % NXCD, off = wgid / NXCD; wgid = (xcd < r ? xcd * (q + 1) : r * (q + 1) + (xcd - r) * q) + off; }
        const int nig = WGM * nN, gid = wgid / nig, fm = gid * WGM, gsz = (nM - fm) < WGM ? (nM - fm) : WGM;
        u.pm = fm + ((wgid % nig) % gsz); u.pn = (wgid % nig) / gsz; return true;
    }
    __device__ __forceinline__ void a_ready(const Unit&) const {}
    __device__ __forceinline__ void done(const Unit&) const {}
};
typedef __bf16 bf16v2_t __attribute__((ext_vector_type(2)));
typedef float f32v2_t __attribute__((ext_vector_type(2)));
typedef unsigned u32x2 __attribute__((ext_vector_type(2)));
__device__ __forceinline__ unsigned pk2(float lo, float hi) { f32v2_t v = {lo, hi}; bf16v2_t b = __builtin_convertvector(v, bf16v2_t); return __builtin_bit_cast(unsigned, b); }
template <int ACT> struct EpiPlain {
    static constexpr bool PERM = true, AFTER_DRAIN = false;
    bf16_t* O; int ldc;
    __device__ __forceinline__ void operator()(const f32x4 (&acc)[2][2][4][2], const Unit& u, int wr, int wc, int fr, int fq) const {
        const int row0 = u.pm * BM + wr * 64 + fr, col0 = u.pn * BM + wc * 32 + 8 * fq;
#pragma unroll
        for (int ai = 0; ai < 2; ++ai)
#pragma unroll
            for (int m = 0; m < 4; ++m) { bf16_t* rowp = O + (size_t)(row0 + ai * HALF + m * 16) * ldc + col0;
#pragma unroll
                for (int bj = 0; bj < 2; ++bj) { f32x4 v0 = acc[ai][bj][m][0], v1 = acc[ai][bj][m][1];
                    if (ACT == 1) {
#pragma unroll
                        for (int j = 0; j < 4; ++j) { const float a = fmaxf(v0[j], 0.f), b = fmaxf(v1[j], 0.f); v0[j] = a * a; v1[j] = b * b; } }
                    u32x4 w; w.x = pk2(v0[0], v0[1]); w.y = pk2(v0[2], v0[3]); w.z = pk2(v1[0], v1[1]); w.w = pk2(v1[2], v1[3]);
                    *(u32x4*)(rowp + bj * HALF) = w; } }
    }
};
struct EpiRope {
    static constexpr bool PERM = true, AFTER_DRAIN = false;
    bf16_t* O; int ldc; const float* cs; const float* sn; int seq_mask;
    __device__ __forceinline__ void operator()(const f32x4 (&acc)[2][2][4][2], const Unit& u, int wr, int wc, int fr, int fq) const {
        const int row0 = u.pm * BM + wr * 64 + fr, col0 = u.pn * BM + wc * 32 + 8 * fq;
        const int ci = 4 * (wc & 1) + fq;
        bool rope[2];
#pragma unroll
        for (int bj = 0; bj < 2; ++bj) { const int head = 4 * u.pn + 2 * bj + (wc >> 1); rope[bj] = (head < 8) || (head >= 22 && head < 34); }
        const bool anyrope = rope[0] || rope[1];
#pragma unroll
        for (int ai = 0; ai < 2; ++ai)
#pragma unroll
            for (int m = 0; m < 4; ++m) { const int row = row0 + ai * HALF + m * 16; bf16_t* rowp = O + (size_t)row * ldc + col0;
                f32x4 c4 = {1.f, 1.f, 1.f, 1.f}, s4 = {0.f, 0.f, 0.f, 0.f};
                if (anyrope) { const int s = row & seq_mask; c4 = *(const f32x4*)(cs + s * 32 + 4 * ci); s4 = *(const f32x4*)(sn + s * 32 + 4 * ci); }
#pragma unroll
                for (int bj = 0; bj < 2; ++bj) { f32x4 v0 = acc[ai][bj][m][0], v1 = acc[ai][bj][m][1];
                    if (rope[bj]) { const f32x4 y0 = v0 * c4 - v1 * s4, y1 = v0 * s4 + v1 * c4; v0 = y0; v1 = y1; }
                    u32x4 w; w.x = pk2(v0[0], v0[1]); w.y = pk2(v0[2], v0[3]); w.z = pk2(v1[0], v1[1]); w.w = pk2(v1[2], v1[3]);
                    *(u32x4*)(rowp + bj * HALF) = w; } }
    }
};

#define PG8_RLX_AGENT __ATOMIC_RELAXED, __HIP_MEMORY_SCOPE_AGENT
struct EpiAny {
    static constexpr bool PERM = true, AFTER_DRAIN = false;
    unsigned char* ws; const float* xin; float* outp; int mode; int l;
    __device__ __forceinline__ void prime(int pm, PG8_LAS unsigned char* lds, int tid) const {
        if (mode >= 3) return;
        if (tid < 256) { const f32x4 p = *(const f32x4*)((const float*)(ws + WS_PS2) + (size_t)(pm * BM + tid) * 4);
            ((PG8_LAS float*)(lds + 140288))[tid] = rsqrtf(((p[0] + p[1]) + (p[2] + p[3])) * (1.0f / 1024.0f) + NORM_EPS); }
    }
    __device__ __forceinline__ void operator()(const f32x4 (&acc)[2][2][4][2], const Unit& u, int wr, int wc, int fr, int fq, PG8_LAS unsigned char* lds, int wid, int lane, int next_pm, int parity) const {
        asm volatile("" : "+v"(fr), "+v"(fq));
        if (mode >= 3) { fused(acc, u, wr, wc, fr, fq, lds, wid, lane); return; }
        bf16_t* O = (bf16_t*)(ws + (mode == 1 ? WS_H : WS_PROJ)); const int ldc = (mode == 1) ? D_FF : PW, seq_mask = SEQ - 1;
        const float* cs = (const float*)(ws + WS_ROPE); const float* sn = cs + SEQ * 32; const float* rowss = (const float*)(ws + WS_PS2); const float eps = NORM_EPS;
        PG8_LAS float* RSC = (PG8_LAS float*)(lds + 140288); const int tid = wid * 64 + lane;
        f32x4 pnext = {0.f, 0.f, 0.f, 0.f};
        if (tid < 256 && next_pm >= 0) pnext = *(const f32x4*)(rowss + (size_t)(next_pm * BM + tid) * 4);
        const int row0 = u.pm * BM + wr * 64 + fr, col0 = u.pn * BM + wc * 32 + 8 * fq;
        const int ci = 4 * (wc & 1) + fq;
        bool rope[2];
#pragma unroll
        for (int bj = 0; bj < 2; ++bj) { const int head = 4 * u.pn + 2 * bj + (wc >> 1); rope[bj] = (mode == 2) && ((head < 8) || (head >= 22 && head < 34)); }
        const bool anyrope = rope[0] || rope[1];
#pragma unroll
        for (int ai = 0; ai < 2; ++ai) {
            f32x4 c4[4], s4[4]; float rsc[4];
#pragma unroll
            for (int m = 0; m < 4; ++m) { c4[m] = (f32x4){1.f, 1.f, 1.f, 1.f}; s4[m] = (f32x4){0.f, 0.f, 0.f, 0.f}; rsc[m] = 1.f; }
#pragma unroll
            for (int m = 0; m < 4; ++m) rsc[m] = RSC[parity * 256 + ai * HALF + wr * 64 + m * 16 + fr];
            if (anyrope) {
#pragma unroll
                for (int m = 0; m < 4; ++m) { const int s = (row0 + ai * HALF + m * 16) & seq_mask; c4[m] = *(const f32x4*)(cs + s * 32 + 4 * ci); s4[m] = *(const f32x4*)(sn + s * 32 + 4 * ci); } }
#pragma unroll
            for (int m = 0; m < 4; ++m) { const int row = row0 + ai * HALF + m * 16; bf16_t* rowp = O + (size_t)row * ldc + col0;
#pragma unroll
                for (int bj = 0; bj < 2; ++bj) { f32x4 v0 = acc[ai][bj][m][0] * rsc[m], v1 = acc[ai][bj][m][1] * rsc[m];
                    if (rope[bj]) { const f32x4 y0 = v0 * c4[m] - v1 * s4[m], y1 = v0 * s4[m] + v1 * c4[m]; v0 = y0; v1 = y1; }
                    if (mode == 1) {
#pragma unroll
                        for (int j = 0; j < 4; ++j) { const float a = fmaxf(v0[j], 0.f), b = fmaxf(v1[j], 0.f); v0[j] = a * a; v1[j] = b * b; } }
                    u32x4 w; w.x = pk2(v0[0], v0[1]); w.y = pk2(v0[2], v0[3]); w.z = pk2(v1[0], v1[1]); w.w = pk2(v1[2], v1[3]);
                    *(u32x4*)(rowp + bj * HALF) = w; } }
            asm volatile("" ::: "memory");
        }
        if (tid < 256 && next_pm >= 0) RSC[(parity ^ 1) * 256 + tid] = rsqrtf(((pnext[0] + pnext[1]) + (pnext[2] + pnext[3])) * (1.0f / 1024.0f) + eps);
    }
    __device__ __forceinline__ void fused(const f32x4 (&acc)[2][2][4][2], const Unit& u, int wr, int wc, int fr, int fq, PG8_LAS unsigned char* lds, int wid, int lane) const {
        asm volatile("" : "+v"(fr), "+v"(fq), "+v"(lane));
        const bool last = (mode == 4) && (l + 1 == DEPTH);
        bf16_t* xb = (bf16_t*)(ws + WS_XB); float* outf = last ? outp : nullptr;
        const float* gains = (const float*)(ws + WS_GAIN);
        const float* gpost = gains + (l * 4 + (mode == 3 ? 1 : 3)) * D_MODEL;
        float* ps1 = (float*)(ws + WS_PS1); float* ps2 = (float*)(ws + WS_PS2); unsigned* cnt = (unsigned*)(ws + WS_CNT) + (size_t)(2 * l + (mode == 4 ? 1 : 0)) * 256 * 16; const float eps = NORM_EPS;
        PG8_LAS float* P1 = (PG8_LAS float*)(lds + 131072);
        PG8_LAS float* S1 = (PG8_LAS float*)(lds + 131072 + 4096);
        PG8_LAS float* P2 = (PG8_LAS float*)(lds + 131072 + 5120);
        const int tid = wid * 64 + lane;
#pragma unroll
        for (int ai = 0; ai < 2; ++ai)
#pragma unroll
            for (int m = 0; m < 4; ++m) { float s = 0.f;
#pragma unroll
                for (int bj = 0; bj < 2; ++bj)
#pragma unroll
                    for (int n = 0; n < 2; ++n) { const f32x4 x = acc[ai][bj][m][n]; s += (x[0] * x[0] + x[1] * x[1]) + (x[2] * x[2] + x[3] * x[3]); }
                s += shx(s, 16); s += shx(s, 32);
                if (fq == 0) P1[(ai * HALF + wr * 64 + m * 16 + fr) * 4 + wc] = s; }
        asm volatile("s_waitcnt lgkmcnt(0)" ::: "memory"); __builtin_amdgcn_s_barrier(); asm volatile("" ::: "memory");
        if (tid < 256) { const f32x4 p = *(const PG8_LAS f32x4*)(P1 + tid * 4);
            __hip_atomic_store(ps1 + ((size_t)(u.pm * BM + tid)) * 4 + u.pn, (p[0] + p[1]) + (p[2] + p[3]), PG8_RLX_AGENT);
            asm volatile("s_waitcnt vmcnt(0)" ::: "memory");
            if (lane == 0) __hip_atomic_fetch_add(cnt + 16 * u.pm, 1u, PG8_RLX_AGENT); }
        if (wid == 0) { unsigned spins = 0;
            while ((unsigned)__builtin_amdgcn_readfirstlane((int)__hip_atomic_load(cnt + 16 * u.pm, PG8_RLX_AGENT)) < 16u) { __builtin_amdgcn_s_sleep(2); if (++spins > (1u << 21)) break; }
            __builtin_amdgcn_fence(__ATOMIC_ACQUIRE, "agent"); asm volatile("s_waitcnt vmcnt(0)" ::: "memory"); }
        asm volatile("s_waitcnt lgkmcnt(0)" ::: "memory"); __builtin_amdgcn_s_barrier(); asm volatile("" ::: "memory");
        if (tid < 256) { const float* q = ps1 + ((size_t)(u.pm * BM + tid)) * 4;
            const float t = (__hip_atomic_load(q, PG8_RLX_AGENT) + __hip_atomic_load(q + 1, PG8_RLX_AGENT)) + (__hip_atomic_load(q + 2, PG8_RLX_AGENT) + __hip_atomic_load(q + 3, PG8_RLX_AGENT));
            S1[tid] = rsqrtf(t * (1.0f / 1024.0f) + eps); }
        asm volatile("s_waitcnt lgkmcnt(0)" ::: "memory"); __builtin_amdgcn_s_barrier(); asm volatile("" ::: "memory");
        const int col0 = u.pn * BM + wc * 32 + 8 * fq;
        f32x4 g1[2][2];
#pragma unroll
        for (int bj = 0; bj < 2; ++bj)
#pragma unroll
            for (int n = 0; n < 2; ++n) { g1[bj][n] = *(const f32x4*)(gpost + col0 + bj * HALF + 4 * n); }
#pragma unroll
        for (int ai = 0; ai < 2; ++ai) {
            u32x4 xq[4][2];
#pragma unroll
            for (int m = 0; m < 4; ++m) { const size_t off = (size_t)(u.pm * BM + ai * HALF + wr * 64 + m * 16 + fr) * 1024 + col0;
#pragma unroll
                for (int bj = 0; bj < 2; ++bj) {
                    xq[m][bj] = *(const u32x4*)(xb + off + bj * HALF); } }
#pragma unroll
            for (int m = 0; m < 4; ++m) { const int rl = ai * HALF + wr * 64 + m * 16 + fr; const size_t off = (size_t)(u.pm * BM + rl) * 1024 + col0; const float rstd = S1[rl]; float s2 = 0.f;
#pragma unroll
                for (int bj = 0; bj < 2; ++bj) { f32x4 x0, x1;
                    { const u32x4 w = xq[m][bj];
                        x0 = (f32x4){__uint_as_float(w.x << 16), __uint_as_float(w.x & 0xffff0000u), __uint_as_float(w.y << 16), __uint_as_float(w.y & 0xffff0000u)};
                        x1 = (f32x4){__uint_as_float(w.z << 16), __uint_as_float(w.z & 0xffff0000u), __uint_as_float(w.w << 16), __uint_as_float(w.w & 0xffff0000u)}; }
                    f32x4 v0 = x0 + acc[ai][bj][m][0] * rstd * g1[bj][0], v1 = x1 + acc[ai][bj][m][1] * rstd * g1[bj][1];
                    if (outf) { float* op = outf + off + bj * HALF; *(f32x4*)op = v0; *(f32x4*)(op + 4) = v1; }
                    else { u32x4 w; w.x = pk2(v0[0], v0[1]); w.y = pk2(v0[2], v0[3]); w.z = pk2(v1[0], v1[1]); w.w = pk2(v1[2], v1[3]);
                        *(u32x4*)(xb + off + bj * HALF) = w;
                        v0 = (f32x4){__uint_as_float(w.x << 16), __uint_as_float(w.x & 0xffff0000u), __uint_as_float(w.y << 16), __uint_as_float(w.y & 0xffff0000u)};
                        v1 = (f32x4){__uint_as_float(w.z << 16), __uint_as_float(w.z & 0xffff0000u), __uint_as_float(w.w << 16), __uint_as_float(w.w & 0xffff0000u)};
                        s2 += ((v0[0] * v0[0] + v0[1] * v0[1]) + (v0[2] * v0[2] + v0[3] * v0[3])) + ((v1[0] * v1[0] + v1[1] * v1[1]) + (v1[2] * v1[2] + v1[3] * v1[3]));
                    } }
                if (!outf) { s2 += shx(s2, 16); s2 += shx(s2, 32); if (fq == 0) P2[rl * 4 + wc] = s2; } }
            asm volatile("" ::: "memory");
        }
        if (!outf) {
            asm volatile("s_waitcnt lgkmcnt(0)" ::: "memory"); __builtin_amdgcn_s_barrier(); asm volatile("" ::: "memory");
            if (tid < 256) { const f32x4 p = *(const PG8_LAS f32x4*)(P2 + tid * 4); ps2[((size_t)(u.pm * BM + tid)) * 4 + u.pn] = (p[0] + p[1]) + (p[2] + p[3]); } }
    }
};
template <class Epi, class Sched, bool ALIGN_EPI = false, bool SP2 = false>
__device__ __forceinline__ void gemm_phase(PG8_LAS unsigned char* lds, const Gemm g, const Sched& S, const Epi& E, const int tid) {
    const int wid = __builtin_amdgcn_readfirstlane(tid >> 6), lane = tid & 63, wr = wid >> 2, wc = wid & 3, fr = lane & 15, fq = lane >> 4;
    const int K = g.K, nt = K / BK;
    unsigned voffA[2], voffB[2];
#pragma unroll
    for (int i = 0; i < 2; ++i) { int R, C; stage_rc(tid * 16 + i * 8192, R, C); const int Rb = Epi::PERM ? ((R & ~31) + perm32(R & 31)) : R;
        voffA[i] = (unsigned)(R * K + C) * 2u; voffB[i] = (unsigned)(Rb * K + C) * 2u; }
    const size_t kstep = (size_t)(BK * 2);
    const size_t hstep = (size_t)HALF * K * 2;
    const size_t tstep = 2 * hstep;
    const unsigned ldsw = (unsigned)wid * 1024u;
    const int aoff = lds_byte(wr * 64 + fr, fq * 8), boff = lds_byte(wc * 32 + fr, fq * 8);
#define PG8_SA(b, h) (((b) * 2 + (h)) * HTB)
#define PG8_SB(b, h) ((4 + (b) * 2 + (h)) * HTB)
#define PG8_STAGE(bufoff, gbase, voff) do { _Pragma("unroll") for (int _i = 0; _i < 2; ++_i) \
        __builtin_amdgcn_global_load_lds((const unsigned*)((const char*)(gbase) + (voff)[_i]), (PG8_LAS unsigned*)(lds + (bufoff) + ldsw + _i * 8192), 16, 0, 0); } while (0)
#define PG8_LDA(dst, b, h) do { _Pragma("unroll") for (int m = 0; m < 4; ++m) _Pragma("unroll") for (int k = 0; k < 2; ++k) dst[m][k] = *(const PG8_LAS bf16x8*)(lds + PG8_SA(b, h) + aoff + m * 2048 + k * 1024); } while (0)
#define PG8_LDB(dst, b, h) do { _Pragma("unroll") for (int n = 0; n < 2; ++n) _Pragma("unroll") for (int k = 0; k < 2; ++k) dst[n][k] = *(const PG8_LAS bf16x8*)(lds + PG8_SB(b, h) + boff + n * 2048 + k * 1024); } while (0)
#define PG8_MMA(ai, bj, At, Bt) do { __builtin_amdgcn_s_setprio(1); _Pragma("unroll") for (int m = 0; m < 4; ++m) _Pragma("unroll") for (int n = 0; n < 2; ++n) _Pragma("unroll") for (int k = 0; k < 2; ++k) \
        acc[ai][bj][m][n] = __builtin_amdgcn_mfma_f32_16x16x32_bf16(Bt[n][k], At[m][k], acc[ai][bj][m][n], 0, 0, 0); __builtin_amdgcn_s_setprio(0); } while (0)
#define PG8_WAIT_V(n) asm volatile("s_waitcnt vmcnt(" #n ")" ::: "memory")
#define PG8_WAIT_L(n) asm volatile("s_waitcnt lgkmcnt(" #n ")" ::: "memory")
#define PG8_BAR __builtin_amdgcn_s_barrier()
#define PG8_SCHED __builtin_amdgcn_sched_barrier(0)
    Unit cur, nxt; int ui = 0;
    if (!S.next(0, cur)) return;
    f32x4 acc[2][2][4][2];
#pragma unroll
    for (int a = 0; a < 2; ++a)
#pragma unroll
        for (int b = 0; b < 2; ++b)
#pragma unroll
            for (int m = 0; m < 4; ++m)
#pragma unroll
                for (int n = 0; n < 2; ++n) acc[a][b][m][n] = (f32x4){0.f, 0.f, 0.f, 0.f};
    bf16x8 At[4][2], B0[2][2], B1[2][2];
    const char* cA = (const char*)g.A + (size_t)cur.pm * tstep; const char* cB = (const char*)g.Bt + (size_t)cur.pn * tstep;
    S.a_ready(cur);
    E.prime(cur.pm, lds, wid * 64 + lane);
    if constexpr (SP2) {
        PG8_STAGE(PG8_SB(0, 0), cB, voffB); PG8_STAGE(PG8_SB(0, 1), cB + hstep, voffB); PG8_STAGE(PG8_SA(0, 0), cA, voffA); PG8_STAGE(PG8_SA(0, 1), cA + hstep, voffA);
        if (wr == 1) PG8_BAR;
        PG8_WAIT_V(2); PG8_BAR;
        PG8_STAGE(PG8_SB(1, 0), cB + kstep, voffB); PG8_STAGE(PG8_SA(1, 0), cA + kstep, voffA); PG8_STAGE(PG8_SB(1, 1), cB + hstep + kstep, voffB);
        PG8_WAIT_V(6); PG8_BAR;
    } else {
        PG8_STAGE(PG8_SB(0, 0), cB, voffB); PG8_STAGE(PG8_SA(0, 0), cA, voffA); PG8_STAGE(PG8_SB(0, 1), cB + hstep, voffB); PG8_STAGE(PG8_SA(0, 1), cA + hstep, voffA);
        if (wr == 1) PG8_BAR;
        PG8_WAIT_V(4); PG8_BAR;
        PG8_STAGE(PG8_SB(1, 0), cB + kstep, voffB); PG8_STAGE(PG8_SA(1, 0), cA + kstep, voffA); PG8_STAGE(PG8_SB(1, 1), cB + hstep + kstep, voffB);
        PG8_WAIT_V(6); PG8_BAR;
    }
    for (;;) {
        const bool has_next = S.next(ui + 1, nxt);
        const char* nA = has_next ? (const char*)g.A + (size_t)nxt.pm * tstep : cA; const char* nB = has_next ? (const char*)g.Bt + (size_t)nxt.pn * tstep : cB;
        for (int t = 0; t < nt; t += 2) {
            const bool last = (t == nt - 2);
            const char* a1 = cA + (size_t)(t + 1) * kstep;
            const char* a2 = last ? nA : cA + (size_t)(t + 2) * kstep; const char* b2 = last ? nB : cB + (size_t)(t + 2) * kstep;
            const char* a3 = a2 + kstep; const char* b3 = b2 + kstep;
            if (last && has_next) S.a_ready(nxt);
            if constexpr (SP2) {
            PG8_LDB(B0, 0, 0); PG8_LDB(B1, 0, 1); PG8_SCHED; PG8_LDA(At, 0, 0); PG8_STAGE(PG8_SA(1, 1), a1 + hstep, voffA);
            PG8_WAIT_V(8); PG8_WAIT_L(0); PG8_BAR; PG8_MMA(0, 0, At, B0); PG8_MMA(0, 1, At, B1); PG8_BAR; PG8_SCHED;
            PG8_LDA(At, 0, 1); PG8_STAGE(PG8_SB(0, 0), b2, voffB); PG8_STAGE(PG8_SB(0, 1), b2 + hstep, voffB); PG8_STAGE(PG8_SA(0, 0), a2, voffA);
            PG8_WAIT_V(8); PG8_WAIT_L(0); PG8_BAR; PG8_MMA(1, 0, At, B0); PG8_MMA(1, 1, At, B1); PG8_BAR; PG8_SCHED;
            PG8_LDB(B0, 1, 0); PG8_LDB(B1, 1, 1); PG8_SCHED; PG8_LDA(At, 1, 0); PG8_STAGE(PG8_SA(0, 1), a2 + hstep, voffA);
            PG8_WAIT_V(8); PG8_WAIT_L(0); PG8_BAR; PG8_MMA(0, 0, At, B0); PG8_MMA(0, 1, At, B1); PG8_BAR; PG8_SCHED;
            PG8_LDA(At, 1, 1); PG8_STAGE(PG8_SB(1, 0), b3, voffB); PG8_STAGE(PG8_SB(1, 1), b3 + hstep, voffB); PG8_STAGE(PG8_SA(1, 0), a3, voffA);
            PG8_WAIT_V(8); PG8_WAIT_L(0); PG8_BAR; PG8_MMA(1, 0, At, B0); PG8_MMA(1, 1, At, B1); PG8_BAR; PG8_SCHED;
            } else {
            PG8_LDB(B0, 0, 0); PG8_SCHED; PG8_LDA(At, 0, 0); PG8_STAGE(PG8_SA(1, 1), a1 + hstep, voffA);
            PG8_WAIT_L(8); PG8_BAR; PG8_WAIT_L(0); PG8_MMA(0, 0, At, B0); PG8_BAR; PG8_SCHED;
            PG8_LDB(B1, 0, 1); PG8_STAGE(PG8_SB(0, 0), b2, voffB);
            PG8_BAR; PG8_WAIT_L(0); PG8_MMA(0, 1, At, B1); PG8_BAR;
            PG8_LDA(At, 0, 1); PG8_STAGE(PG8_SA(0, 0), a2, voffA);
            PG8_BAR; PG8_WAIT_L(0); PG8_MMA(1, 0, At, B0); PG8_BAR; PG8_SCHED;
            PG8_STAGE(PG8_SB(0, 1), b2 + hstep, voffB);
            PG8_WAIT_V(6); PG8_BAR; PG8_MMA(1, 1, At, B1); PG8_BAR;
            PG8_LDB(B0, 1, 0); PG8_SCHED; PG8_LDA(At, 1, 0); PG8_STAGE(PG8_SA(0, 1), a2 + hstep, voffA);
            PG8_WAIT_L(8); PG8_BAR; PG8_WAIT_L(0); PG8_MMA(0, 0, At, B0); PG8_BAR; PG8_SCHED;
            PG8_LDB(B1, 1, 1); PG8_STAGE(PG8_SB(1, 0), b3, voffB);
            PG8_BAR; PG8_WAIT_L(0); PG8_MMA(0, 1, At, B1); PG8_BAR;
            PG8_LDA(At, 1, 1); PG8_STAGE(PG8_SA(1, 0), a3, voffA);
            PG8_BAR; PG8_WAIT_L(0); PG8_MMA(1, 0, At, B0); PG8_BAR; PG8_SCHED;
            PG8_STAGE(PG8_SB(1, 1), b3 + hstep, voffB);
            PG8_WAIT_V(6); PG8_BAR; PG8_MMA(1, 1, At, B1); PG8_BAR;
            }
        }
        if constexpr (ALIGN_EPI) { if (wr == 0) PG8_BAR; }
        if constexpr (!Epi::AFTER_DRAIN) { E(acc, cur, wr, wc, fr, fq, lds, wid, lane, has_next ? nxt.pm : -1, ui & 1); S.done(cur); }
        if (!has_next) break;
#pragma unroll
        for (int a = 0; a < 2; ++a)
#pragma unroll
            for (int b = 0; b < 2; ++b)
#pragma unroll
                for (int m = 0; m < 4; ++m)
#pragma unroll
                    for (int n = 0; n < 2; ++n) acc[a][b][m][n] = (f32x4){0.f, 0.f, 0.f, 0.f};
        cur = nxt; cA = nA; cB = nB; ++ui;
        if constexpr (ALIGN_EPI) { if (wr == 1) PG8_BAR; }
    }
    PG8_WAIT_V(0);
    if constexpr (!ALIGN_EPI) { if (wr == 0) PG8_BAR; }
    PG8_BAR;
    if constexpr (Epi::AFTER_DRAIN) { E.fused(acc, cur, wr, wc, fr, fq, lds, wid, lane); S.done(cur); }
#undef PG8_SA
#undef PG8_SB
#undef PG8_STAGE
#undef PG8_LDA
#undef PG8_LDB
#undef PG8_MMA
#undef PG8_WAIT_V
#undef PG8_WAIT_L
#undef PG8_BAR
#undef PG8_SCHED
}
}
#define LAS __attribute__((address_space(3)))
typedef LAS unsigned char* ldsp;
typedef unsigned short bf16_t;
typedef short bf16x8 __attribute__((ext_vector_type(8)));
typedef short s16x4 __attribute__((ext_vector_type(4)));
typedef float f32x4 __attribute__((ext_vector_type(4)));
typedef float f32x16 __attribute__((ext_vector_type(16)));
typedef unsigned u32x4 __attribute__((ext_vector_type(4)));
typedef unsigned u32x2 __attribute__((ext_vector_type(2)));
using pg8::pk2;
#define DI __device__ __forceinline__
#define LDS_WAIT() asm volatile("s_waitcnt lgkmcnt(0)" ::: "memory")

DI f32x16 mfma32(bf16x8 a, bf16x8 b, f32x16 c) { return __builtin_amdgcn_mfma_f32_32x32x16_bf16(a, b, c, 0, 0, 0); }
DI constexpr int crow(int i, int h) { return (i & 3) + 8 * (i >> 2) + 4 * h; }
DI float bf2f(unsigned short b) { return __uint_as_float(((unsigned)b) << 16); }
DI f32x16 zero16() { f32x16 z;
#pragma unroll
  for (int i = 0; i < 16; ++i) z[i] = 0.f; return z; }
DI bf16x8 pack8(const f32x16& x, const int s) { u32x4 p; p.x = pk2(x[8 * s], x[8 * s + 1]); p.y = pk2(x[8 * s + 2], x[8 * s + 3]); p.z = pk2(x[8 * s + 4], x[8 * s + 5]); p.w = pk2(x[8 * s + 6], x[8 * s + 7]); return __builtin_bit_cast(bf16x8, p); }
DI float lg2gamma(int head) { return log2f(1.0f - exp2f(-5.0f - (float)head)); }
DI int launder(int x) { asm volatile("" : "+v"(x)); return x; }
template <int CTRL> DI float dpp_add(float v) { return v + __int_as_float(__builtin_amdgcn_update_dpp(0, __float_as_int(v), CTRL, 0xF, 0xF, true)); }
DI float wave_sum(float v) {
    v = dpp_add<0xB1>(v);
    v = dpp_add<0x4E>(v);
    v = dpp_add<0x141>(v);
    v = dpp_add<0x140>(v);
    v += __int_as_float(__builtin_amdgcn_ds_swizzle(__float_as_int(v), 0x401F));
    v += shx(v, 32);
    return v; }

#define XB_TMO      128
#define XB_XCNT(j)  (256  + 64 * (j))
#define XB_XSUB(j)  (1280 + 64 * (j))
#define XB_XGEN(j)  (2304 + 64 * (j))
#define XB_TOP      3328
#define XB_TOPGEN   3392
#define XCD_BAR_WORDS 3456
#define XB_SPIN_CAP (1u << 18)

__device__ __forceinline__ unsigned xb_ld(unsigned* p)              { return __hip_atomic_load(p, __ATOMIC_RELAXED, __HIP_MEMORY_SCOPE_AGENT); }
__device__ __forceinline__ unsigned xb_add(unsigned* p, unsigned v) { return __hip_atomic_fetch_add(p, v, __ATOMIC_RELAXED, __HIP_MEMORY_SCOPE_AGENT); }
__device__ __forceinline__ unsigned xb_xcc_id() { return (unsigned)__builtin_amdgcn_s_getreg((3 << 11) | 20) & 0xFu; }
#define XB_SPIN(cond, bar) do { unsigned _sp = 0; while (cond) { __builtin_amdgcn_s_sleep(1); \
    if ((++_sp & 255u) == 0u) { if (xb_ld(&(bar)[XB_TMO])) break; if (_sp > XB_SPIN_CAP) { atomicAdd(&(bar)[XB_TMO], 1u); break; } } } } while (0)

struct XcdBarrier {
    unsigned* bar; unsigned x;
    volatile LAS unsigned* st;
};

__device__ __forceinline__ XcdBarrier xcd_barrier_post(unsigned* bar, volatile LAS unsigned* st) {
    XcdBarrier b; b.bar = bar; b.x = xb_xcc_id(); b.st = st;
    if (threadIdx.x == 0) (void)xb_add(&bar[XB_XCNT(b.x)], 1u);
    return b;
}
__device__ __forceinline__ void xcd_barrier_complete(unsigned* bar, unsigned x, unsigned& nloc, unsigned& nx) {
    const unsigned G = gridDim.x * gridDim.y * gridDim.z;
    unsigned sum, cnt, mine, sp = 0u;
    for (;;) {
        sum = 0u; cnt = 0u; mine = 0u;
#pragma unroll
        for (unsigned j = 0; j < 16; ++j) { const unsigned c = xb_ld(&bar[XB_XCNT(j)]); sum += c; cnt += (c > 0u) ? 1u : 0u; mine = (j == x) ? c : mine; }
        if (sum == G) break;
        __builtin_amdgcn_s_sleep(1);
        if ((++sp & 255u) == 0u) { if (xb_ld(&bar[XB_TMO])) break; if (sp > XB_SPIN_CAP) { atomicAdd(&bar[XB_TMO], 1u); break; } }
    }
    nloc = mine > 0u ? mine : 1u; nx = cnt > 0u ? cnt : 1u;
}

__device__ __forceinline__ void xcd_barrier(const XcdBarrier& b) {
    asm volatile("s_waitcnt vmcnt(0)" ::: "memory");
    __syncthreads();
    if (threadIdx.x == 0) {
        unsigned* bar = b.bar;
        __builtin_amdgcn_s_waitcnt(0);
        unsigned nloc = b.st[0], nx = b.st[1];
        if (nloc == 0u) { xcd_barrier_complete(bar, b.x, nloc, nx); b.st[0] = nloc; b.st[1] = nx; }
        const unsigned old = xb_add(&bar[XB_XSUB(b.x)], 1u);
        const unsigned gen = old / nloc;
        if (old + 1u == (gen + 1u) * nloc) {
            __builtin_amdgcn_fence(__ATOMIC_RELEASE, "agent");
            asm volatile("s_waitcnt vmcnt(0)" ::: "memory");
            const unsigned og = xb_add(&bar[XB_TOP], 1u);
            const unsigned tg = og / nx;
            if (og + 1u == (tg + 1u) * nx) xb_add(&bar[XB_TOPGEN], 1u);
            else XB_SPIN(xb_ld(&bar[XB_TOPGEN]) == tg, bar);
            __builtin_amdgcn_fence(__ATOMIC_ACQUIRE, "agent");
            xb_add(&bar[XB_XGEN(b.x)], 1u);
            asm volatile("s_waitcnt vmcnt(0)" ::: "memory");
        } else {
            XB_SPIN(xb_ld(&bar[XB_XGEN(b.x)]) == gen, bar);
            __builtin_amdgcn_fence(__ATOMIC_ACQUIRE, "agent");
            asm volatile("s_waitcnt vmcnt(0)" ::: "memory");
        }
    }
    __syncthreads();
}

DI void stage_rows(ldsp dst, const bf16_t* src, size_t pitch, int nrows, int tid) {
    for (int it = tid; it < nrows * 8; it += NTHREADS) { const int r = it >> 3, c = it & 7;
        const u32x4 v = *(const u32x4*)(src + (size_t)r * pitch + c * 8);
        *(LAS u32x4*)(dst + r * 144 + c * 16) = v; }
}
template <int NT> DI void stage_tiles(ldsp lds, const int (&dstoff)[NT], const bf16_t* const (&src)[NT], const float (&lg)[NT], int tid) {
    u32x4 v[NT][2];
    const int r0 = tid >> 3, c = tid & 7;
#pragma unroll
    for (int t = 0; t < NT; ++t)
#pragma unroll
        for (int i = 0; i < 2; ++i) v[t][i] = *(const u32x4*)(src[t] + (size_t)(r0 + 64 * i) * PW + c * 8);
#pragma unroll
    for (int t = 0; t < NT; ++t)
#pragma unroll
        for (int i = 0; i < 2; ++i) { u32x4 o = v[t][i];
            if (lg[t] != 0.f) { const float sc = exp2f((float)(127 - (r0 + 64 * i)) * lg[t]);
                o.x = pk2(__uint_as_float(o.x << 16) * sc, __uint_as_float(o.x & 0xffff0000u) * sc); o.y = pk2(__uint_as_float(o.y << 16) * sc, __uint_as_float(o.y & 0xffff0000u) * sc);
                o.z = pk2(__uint_as_float(o.z << 16) * sc, __uint_as_float(o.z & 0xffff0000u) * sc); o.w = pk2(__uint_as_float(o.w << 16) * sc, __uint_as_float(o.w & 0xffff0000u) * sc); }
            *(LAS u32x4*)(lds + dstoff[t] + (r0 + 64 * i) * 144 + c * 16) = o; }
}
DI void stage_rows_scaled(ldsp dst, const bf16_t* src, size_t pitch, int nrows, int tid, float lg) {
    for (int it = tid; it < nrows * 8; it += NTHREADS) { const int r = it >> 3, c = it & 7;
        const u32x4 v = *(const u32x4*)(src + (size_t)r * pitch + c * 8); const float sc = exp2f((float)(127 - r) * lg);
        u32x4 o; o.x = pk2(__uint_as_float(v.x << 16) * sc, __uint_as_float(v.x & 0xffff0000u) * sc); o.y = pk2(__uint_as_float(v.y << 16) * sc, __uint_as_float(v.y & 0xffff0000u) * sc);
        o.z = pk2(__uint_as_float(v.z << 16) * sc, __uint_as_float(v.z & 0xffff0000u) * sc); o.w = pk2(__uint_as_float(v.w << 16) * sc, __uint_as_float(v.w & 0xffff0000u) * sc);
        *(LAS u32x4*)(dst + r * 144 + c * 16) = o; }
}
template <bool SCALE> DI void stage_T(ldsp dst, int stride, int key0, const bf16_t* src, size_t pitch, int nrows, int tid, float lg) {
    for (int it = tid; it < nrows * 8; it += NTHREADS) { const int r = it >> 3, c = it & 7;
        const u32x4 v = *(const u32x4*)(src + (size_t)r * pitch + c * 8);
        unsigned w[4] = {v.x, v.y, v.z, v.w};
        float sc = 1.f; if (SCALE) sc = exp2f((float)(127 - r) * lg);
#pragma unroll
        for (int j = 0; j < 8; ++j) { unsigned short e = (unsigned short)((j & 1) ? (w[j >> 1] >> 16) : (w[j >> 1] & 0xffffu));
            if (SCALE) { e = (unsigned short)(pk2(bf2f(e) * sc, 0.f) & 0xffffu); }
            *(LAS unsigned short*)(dst + ((8 * c + j) * stride + key0 + r) * 2) = e; } }
}
DI bf16x8 kfrag(ldsp Kb, int row, int kk, int h) { return *(const LAS bf16x8*)(Kb + row * 144 + (16 * kk + 8 * h) * 2); }
DI bf16x8 vtfrag_perm(ldsp Vb, int stride, int row, int key0, int h) {
    const s16x4 lo = *(const LAS s16x4*)(Vb + (row * stride + key0 + 4 * h) * 2), hi = *(const LAS s16x4*)(Vb + (row * stride + key0 + 8 + 4 * h) * 2);
    return __builtin_shufflevector(lo, hi, 0, 1, 2, 3, 4, 5, 6, 7); }
DI int vt_lane_off(int lane) { const int i = lane & 15; return (i >> 2) * 144 + (16 * ((lane >> 4) & 1) + 4 * (i & 3)) * 2; }
DI s16x4 tr_read(ldsp p) { return __builtin_amdgcn_ds_read_tr16_b64_v4i16((LAS s16x4*)p); }
DI bf16x8 vfrag_perm_tr(ldsp Vb, int loff, int col0, int key0, int h) {
    ldsp p = Vb + (key0 + 4 * h) * 144 + col0 * 2 + loff;
    const s16x4 lo = tr_read(p), hi = tr_read(p + 8 * 144);
    return __builtin_shufflevector(lo, hi, 0, 1, 2, 3, 4, 5, 6, 7); }
DI bf16x8 vfrag_nat_tr(ldsp Vb, int loff, int col0, int key0, int h) {
    ldsp p = Vb + (key0 + 8 * h) * 144 + col0 * 2 + loff;
    const s16x4 lo = tr_read(p), hi = tr_read(p + 4 * 144);
    return __builtin_shufflevector(lo, hi, 0, 1, 2, 3, 4, 5, 6, 7); }
DI bf16x8 vtfrag_nat(ldsp Vb, int stride, int row, int key0, int h) {
    const s16x4 lo = *(const LAS s16x4*)(Vb + (row * stride + key0 + 8 * h) * 2), hi = *(const LAS s16x4*)(Vb + (row * stride + key0 + 8 * h + 4) * 2);
    return __builtin_shufflevector(lo, hi, 0, 1, 2, 3, 4, 5, 6, 7); }

DI void swa_unit(ldsp lds, int u, const bf16_t* PROJ, bf16_t* MIXED, const float* sinks, const float* ga, int tid) {
    tid = launder(tid);
    const int b = u >> 6, nb = u & 63;
    const size_t tok0 = (size_t)b * SEQ + (size_t)nb * 128, prev0 = nb > 0 ? tok0 - 128 : tok0;
    ldsp Ks = lds, VTs = lds + 73728; LAS float* xs = (LAS float*)(lds + 147456);
    __syncthreads();
    {   const int dsto[8] = {0, 128 * 144, 36864, 36864 + 128 * 144, 73728, 73728 + 128 * 144, 73728 + 36864, 73728 + 36864 + 128 * 144};
        const bf16_t* const srcs[8] = {PROJ + prev0 * PW + C_KA, PROJ + tok0 * PW + C_KA, PROJ + prev0 * PW + C_KA + 64, PROJ + tok0 * PW + C_KA + 64,
                                       PROJ + prev0 * PW + C_VA, PROJ + tok0 * PW + C_VA, PROJ + prev0 * PW + C_VA + 64, PROJ + tok0 * PW + C_VA + 64};
        const float lgs[8] = {0.f, 0.f, 0.f, 0.f, 0.f, 0.f, 0.f, 0.f};
        stage_tiles<8>(lds, dsto, srcs, lgs, tid); }
    __syncthreads();
    const int wave = __builtin_amdgcn_readfirstlane(tid >> 6), lane = tid & 63, rt = wave & 3, hk = wave >> 2, qi = lane & 31, h = lane >> 5;
    const int qrow = 32 * rt + qi; const size_t token = tok0 + qrow;
    ldsp Kh = Ks + hk * 36864, Vh = VTs + hk * 36864; const int loff = vt_lane_off(lane);
    u32x2 Op[3][2][4]; float ssq = 0.f;
#pragma unroll
    for (int hh = 0; hh < 3; ++hh) {
        const int head = 3 * hk + hh; f32x16 O[2];
        bf16x8 q[4];
#pragma unroll
        for (int kk = 0; kk < 4; ++kk) q[kk] = *(const bf16x8*)(PROJ + token * PW + C_QA + head * 64 + 16 * kk + 8 * h);
        const float sink = sinks[head]; float mx = sink, den = 1.0f;
        O[0] = zero16(); O[1] = zero16();
#pragma unroll
        for (int ti = 0; ti < 5; ++ti) {
            f32x16 s = zero16();
#pragma unroll
            for (int kk = 0; kk < 4; ++kk) s = mfma32(kfrag(Kh, 32 * (rt + ti) + qi, kk, h), q[kk], s);
            float tm = -INFINITY;
            const int kb0 = 32 * (rt + ti) + 4 * h, lo_t = launder(max(qrow, nb > 0 ? -1 : 127) - kb0), hi_t = launder(128 + qrow - kb0);
#pragma unroll
            for (int i = 0; i < 16; ++i) { const int c = (i & 3) + 8 * (i >> 2);
                const bool valid = (c > lo_t) && (c <= hi_t);
                const float v = valid ? s[i] : -INFINITY; s[i] = v; tm = fmaxf(tm, v); }
            tm = fmaxf(tm, shx(tm, 32));
            const float mn = fmaxf(mx, tm), sc = __expf(mx - mn); mx = mn;
            float ps = 0.f;
#pragma unroll
            for (int i = 0; i < 16; ++i) { const float p = __expf(s[i] - mn); s[i] = p; ps += p; }
            den = den * sc + ps;
#pragma unroll
            for (int dd = 0; dd < 2; ++dd)
#pragma unroll
                for (int i = 0; i < 16; ++i) O[dd][i] *= sc;
#pragma unroll
            for (int s2 = 0; s2 < 2; ++s2) { const bf16x8 P = pack8(s, s2);
#pragma unroll
                for (int dd = 0; dd < 2; ++dd) O[dd] = mfma32(vfrag_perm_tr(Vh, loff, 32 * dd, 32 * (rt + ti) + 16 * s2, h), P, O[dd]); }
            asm volatile("" ::: "memory");
        }
        den += shx(den, 32) - __expf(sink - mx);
        const float inv = 1.0f / den;
#pragma unroll
        for (int dd = 0; dd < 2; ++dd)
#pragma unroll
            for (int i = 0; i < 16; ++i) { const float o = O[dd][i] * inv; O[dd][i] = o; ssq += o * o; }
#pragma unroll
        for (int dd = 0; dd < 2; ++dd)
#pragma unroll
            for (int g = 0; g < 4; ++g) { Op[hh][dd][g].x = pk2(O[dd][4 * g], O[dd][4 * g + 1]); Op[hh][dd][g].y = pk2(O[dd][4 * g + 2], O[dd][4 * g + 3]); }
    }
    ssq += shx(ssq, 32);
    if (h == 0) xs[hk * 128 + qrow] = ssq;
    __syncthreads();
    const float rstd = rsqrtf((xs[qrow] + xs[128 + qrow]) * (1.0f / 384.0f) + NORM_EPS);
#pragma unroll
    for (int hh = 0; hh < 3; ++hh)
#pragma unroll
        for (int dd = 0; dd < 2; ++dd)
#pragma unroll
            for (int g = 0; g < 4; ++g) { const int col = (3 * hk + hh) * 64 + 32 * dd + 8 * g + 4 * h; const f32x4 gg = *(const f32x4*)(ga + col);
                const u32x2 pk = Op[hh][dd][g]; const float o0 = __uint_as_float(pk.x << 16), o1 = __uint_as_float(pk.x & 0xffff0000u), o2 = __uint_as_float(pk.y << 16), o3 = __uint_as_float(pk.y & 0xffff0000u);
                u32x2 w; w.x = pk2(o0 * rstd * gg[0], o1 * rstd * gg[1]); w.y = pk2(o2 * rstd * gg[2], o3 * rstd * gg[3]);
                *(u32x2*)(MIXED + token * D_MODEL + col) = w; }
}

DI float sb_tile(ldsp Kh, ldsp Vh, int loff, const bf16x8 (&q)[4], f32x16 (&O)[2], float R, int kt, bool diag, int qi, int h) {
    f32x16 z = zero16();
#pragma unroll
    for (int kk = 0; kk < 4; ++kk) z = mfma32(kfrag(Kh, 32 * kt + qi, kk, h), q[kk], z);
    const int lim = launder(diag ? (qi - 4 * h) : 64);
    float lb[16], v[16];
#pragma unroll
    for (int i = 0; i < 16; ++i) { const float zz = z[i], e = __expf(-fabsf(zz)), l = fminf(zz, 0.f) - __logf(1.0f + e);
        const bool strict = ((i & 3) + 8 * (i >> 2)) < lim; lb[i] = l; v[i] = strict ? (l - zz) : 0.f; }
    float t[16], G[4], P[4], off[4];
#pragma unroll
    for (int g = 0; g < 4; ++g) { t[4 * g + 3] = 0.f; t[4 * g + 2] = v[4 * g + 3]; t[4 * g + 1] = t[4 * g + 2] + v[4 * g + 2]; t[4 * g] = t[4 * g + 1] + v[4 * g + 1]; G[g] = t[4 * g] + v[4 * g]; }
#pragma unroll
    for (int g = 0; g < 4; ++g) P[g] = shx(G[g], 32);
    float run = 0.f;
#pragma unroll
    for (int g = 3; g >= 0; --g) { off[g] = h ? run : (run + P[g]); run += (G[g] + P[g]); }
#pragma unroll
    for (int i = 0; i < 16; ++i) { const bool strict = ((i & 3) + 8 * (i >> 2)) < lim;
        const float w = strict ? __expf(lb[i] + t[i] + off[i >> 2] + R) : 0.f; z[i] = w; }
#pragma unroll
    for (int s2 = 0; s2 < 2; ++s2) { const bf16x8 Pk = pack8(z, s2);
#pragma unroll
        for (int dd = 0; dd < 2; ++dd) O[dd] = mfma32(vfrag_perm_tr(Vh, loff, 32 * dd, 32 * kt + 16 * s2, h), Pk, O[dd]); }
    return R + run;
}
DI void sb_unit(ldsp lds, int u, const bf16_t* PROJ, bf16_t* MIXED, const float* gb, int tid) {
    tid = launder(tid);
    const int b = u >> 6, nb = u & 63;
    const size_t tok0 = (size_t)b * SEQ + (size_t)nb * 128;
    ldsp Ks = lds, VTs = lds + 73728; LAS int* flags = (LAS int*)(lds + 147456); LAS float* xs = (LAS float*)(lds + 147456 + 64);
    const int wave = __builtin_amdgcn_readfirstlane(tid >> 6), lane = tid & 63, p = wave & 3, hs = wave >> 2, qi = lane & 31, h = lane >> 5;
    const int loff = vt_lane_off(lane);
    bf16x8 q[2][4]; f32x16 O[2][2]; float R[2]; bool live[2];
#pragma unroll
    for (int it = 0; it < 2; ++it) { const int head = 2 * hs + it, rt = it ? 3 - p : p; const size_t token = tok0 + 32 * rt + qi;
#pragma unroll
        for (int kk = 0; kk < 4; ++kk) q[it][kk] = *(const bf16x8*)(PROJ + token * PW + C_QB + head * 64 + 16 * kk + 8 * h);
        O[it][0] = zero16(); O[it][1] = zero16(); R[it] = 0.f; live[it] = true; }
    int iter = 0;
    for (int kb = nb; kb >= 0; --kb) {
        __syncthreads();
        const size_t kt0 = (size_t)b * SEQ + (size_t)kb * 128;
        {   const int dsto[8] = {0, 18432, 36864, 55296, 73728, 73728 + 18432, 73728 + 36864, 73728 + 55296};
            const bf16_t* kp = PROJ + kt0 * PW + C_KB; const bf16_t* vp = PROJ + kt0 * PW + C_VB;
            const bf16_t* const srcs[8] = {kp, kp + 64, kp + 128, kp + 192, vp, vp + 64, vp + 128, vp + 192};
            const float lgs[8] = {0.f, 0.f, 0.f, 0.f, 0.f, 0.f, 0.f, 0.f};
            stage_tiles<8>(lds, dsto, srcs, lgs, tid); }
        __syncthreads();
#pragma unroll
        for (int it = 0; it < 2; ++it) {
            if (live[it]) { const int head = 2 * hs + it, rt = it ? 3 - p : p; ldsp Kh = Ks + head * 18432, Vh = VTs + head * 18432;
                for (int kt = (kb == nb) ? rt : 3; kt >= 0; --kt) {
                    R[it] = sb_tile(Kh, Vh, loff, q[it], O[it], R[it], kt, (kb == nb) && (kt == rt), qi, h);
                    if (__all(R[it] < SB_THR)) { live[it] = false; break; }
                }
            }
        }
        if (lane == 0) flags[(iter & 1) * 8 + wave] = (live[0] || live[1]) ? 1 : 0;
        __syncthreads();
        int any = 0;
#pragma unroll
        for (int w2 = 0; w2 < 8; ++w2) any |= flags[(iter & 1) * 8 + w2];
        ++iter;
        if (!any) break;
    }
#pragma unroll
    for (int it = 0; it < 2; ++it) { float ssq = 0.f;
#pragma unroll
        for (int dd = 0; dd < 2; ++dd)
#pragma unroll
            for (int i = 0; i < 16; ++i) ssq += O[it][dd][i] * O[it][dd][i];
        ssq += shx(ssq, 32);
        if (h == 0) xs[(2 * hs + it) * 128 + 32 * (it ? 3 - p : p) + qi] = ssq; }
    __syncthreads();
#pragma unroll
    for (int it = 0; it < 2; ++it) { const int head = 2 * hs + it, rt = it ? 3 - p : p, qrow = 32 * rt + qi; const size_t token = tok0 + qrow;
        const float rstd = rsqrtf(((xs[qrow] + xs[128 + qrow]) + (xs[256 + qrow] + xs[384 + qrow])) * (1.0f / 256.0f) + NORM_EPS);
#pragma unroll
        for (int dd = 0; dd < 2; ++dd)
#pragma unroll
            for (int g = 0; g < 4; ++g) { const int col = head * 64 + 32 * dd + 8 * g + 4 * h; const f32x4 gg = *(const f32x4*)(gb + col);
                u32x2 w; w.x = pk2(O[it][dd][4 * g] * rstd * gg[0], O[it][dd][4 * g + 1] * rstd * gg[1]); w.y = pk2(O[it][dd][4 * g + 2] * rstd * gg[2], O[it][dd][4 * g + 3] * rstd * gg[3]);
                *(u32x2*)(MIXED + token * D_MODEL + 384 + col) = w; } }
}

DI void ret_kv_load(u32x4 (&v)[4][2], int u2, const bf16_t* PROJ, int tid) {
    const int hp = u2 % 3, n = (u2 / 3) & 63, b = u2 / 192;
    const size_t tok0 = (size_t)b * SEQ + (size_t)n * 128;
    const bf16_t* kp = PROJ + tok0 * PW + C_KC + (2 * hp) * 64; const bf16_t* vp = PROJ + tok0 * PW + C_VC + (2 * hp) * 64;
    const int r0 = tid >> 3, c = tid & 7;
#pragma unroll
    for (int i = 0; i < 2; ++i) { const size_t ro = (size_t)(r0 + 64 * i) * PW + c * 8;
        v[0][i] = *(const u32x4*)(kp + ro); v[1][i] = *(const u32x4*)(kp + 64 + ro); v[2][i] = *(const u32x4*)(vp + ro); v[3][i] = *(const u32x4*)(vp + 64 + ro); }
}
DI void ret_kv_unit(ldsp lds, int u2, const u32x4 (&v)[4][2], float* KV, int tid) {
    const int hp = u2 % 3, n = (u2 / 3) & 63, b = u2 / 192;
    ldsp KTs = lds, VTs = lds + 36864;
    {   const int r0 = tid >> 3, c = tid & 7;
#pragma unroll
        for (int t = 0; t < 4; ++t)
#pragma unroll
            for (int i = 0; i < 2; ++i) { u32x4 o = v[t][i];
                if (t < 2) { const float sc = exp2f((float)(127 - (r0 + 64 * i)) * lg2gamma(2 * hp + t));
                    o.x = pk2(__uint_as_float(o.x << 16) * sc, __uint_as_float(o.x & 0xffff0000u) * sc); o.y = pk2(__uint_as_float(o.y << 16) * sc, __uint_as_float(o.y & 0xffff0000u) * sc);
                    o.z = pk2(__uint_as_float(o.z << 16) * sc, __uint_as_float(o.z & 0xffff0000u) * sc); o.w = pk2(__uint_as_float(o.w << 16) * sc, __uint_as_float(o.w & 0xffff0000u) * sc); }
                *(LAS u32x4*)(lds + t * 18432 + (r0 + 64 * i) * 144 + c * 16) = o; } }
}
DI void ret_kv_compute(ldsp lds, int u2, float* KV, int tid) {
    const int hp = u2 % 3, n = (u2 / 3) & 63, b = u2 / 192;
    ldsp KTs = lds, VTs = lds + 36864;
    const int wave = __builtin_amdgcn_readfirstlane(tid >> 6), lane = tid & 63, hs = wave >> 2, eh = (wave >> 1) & 1, dh = wave & 1, r = lane & 31, h = lane >> 5;
    const int head = 2 * hp + hs;
    f32x16 acc = zero16();
    const int loff = vt_lane_off(lane);
#pragma unroll
    for (int s = 0; s < 8; ++s) acc = mfma32(vfrag_nat_tr(VTs + hs * 18432, loff, 32 * eh, 16 * s, h), vfrag_nat_tr(KTs + hs * 18432, loff, 32 * dh, 16 * s, h), acc);
    float* base = KV + ((size_t)(b * 6 + head) * 64 + n) * 4096;
#pragma unroll
    for (int i = 0; i < 16; ++i) base[(32 * eh + crow(i, h)) * 64 + 32 * dh + r] = acc[i];
}
DI void ret_scan_phase(float* KV, int tid, int bid) {
    typedef float f32x2s __attribute__((ext_vector_type(2)));
    const int total2 = BATCH * 6 * 2048;
    for (int idx = bid * NTHREADS + tid; idx < total2; idx += gridDim.x * NTHREADS) {
        const int bh = idx >> 11, ed = (idx & 2047) * 2, head = bh % 6; const float cd = exp2f(128.0f * lg2gamma(head));
        float* p = KV + (size_t)bh * 64 * 4096 + ed; f32x2s s = {0.f, 0.f};
#pragma unroll 32
        for (int n = 0; n < 64; ++n) { const f32x2s t = *(const f32x2s*)(p + (size_t)n * 4096); *(f32x2s*)(p + (size_t)n * 4096) = s; s = s * cd + t; }
    }
}
DI void ret_out_unit(ldsp lds, int u2, const bf16_t* PROJ, const float* KV, bf16_t* MIXED, const float* gcn, int tid, const float* toutc) {
    tid = launder(tid);
    const int hp = u2 % 3, n = (u2 / 3) & 63, b = u2 / 192;
    const size_t tok0 = (size_t)b * SEQ + (size_t)n * 128;
    ldsp Ks = lds, VTs = lds + 36864;
    __syncthreads();
    {   const int dsto[4] = {0, 18432, 36864, 36864 + 18432};
        const bf16_t* kp = PROJ + tok0 * PW + C_KC + (2 * hp) * 64; const bf16_t* vp = PROJ + tok0 * PW + C_VC + (2 * hp) * 64;
        const bf16_t* const srcs[4] = {kp, kp + 64, vp, vp + 64};
        const float lgs[4] = {0.f, 0.f, 0.f, 0.f};
        stage_tiles<4>(lds, dsto, srcs, lgs, tid); }
    __syncthreads();
    const int wave = __builtin_amdgcn_readfirstlane(tid >> 6), lane = tid & 63, hs = wave >> 2, rt = wave & 3, qi = lane & 31, h = lane >> 5;
    const int head = 2 * hp + hs, qrow = 32 * rt + qi; const size_t token = tok0 + qrow;
    ldsp Kh = Ks + hs * 18432, Vh = VTs + hs * 18432; const int loff = vt_lane_off(lane);
    const float lg = lg2gamma(head);
    bf16x8 q[4];
#pragma unroll
    for (int kk = 0; kk < 4; ++kk) q[kk] = *(const bf16x8*)(PROJ + token * PW + C_QC + head * 64 + 16 * kk + 8 * h);
    f32x16 cross[2], intra[2];
    const float* ST = KV + ((size_t)(b * 6 + head) * 64 + n) * 4096;
#pragma unroll
    for (int eh = 0; eh < 2; ++eh) { cross[eh] = zero16(); intra[eh] = zero16();
#pragma unroll
        for (int kk = 0; kk < 4; ++kk) { const float* p = ST + (32 * eh + qi) * 64 + 16 * kk + 8 * h; const f32x4 a0 = *(const f32x4*)p, a1 = *(const f32x4*)(p + 4);
            u32x4 pa; pa.x = pk2(a0[0], a0[1]); pa.y = pk2(a0[2], a0[3]); pa.z = pk2(a1[0], a1[1]); pa.w = pk2(a1[2], a1[3]);
            cross[eh] = mfma32(__builtin_bit_cast(bf16x8, pa), q[kk], cross[eh]); } }
    for (int kt = 0; kt <= rt; ++kt) {
        f32x16 s = zero16();
#pragma unroll
        for (int kk = 0; kk < 4; ++kk) s = mfma32(kfrag(Kh, 32 * kt + qi, kk, h), q[kk], s);
        const int dbase = launder(qrow - 32 * kt - 4 * h);
#pragma unroll
        for (int i = 0; i < 16; ++i) { const int dlt = dbase - ((i & 3) + 8 * (i >> 2)); s[i] = dlt >= 0 ? s[i] * exp2f((float)dlt * lg) : 0.f; }
#pragma unroll
        for (int s2 = 0; s2 < 2; ++s2) { const bf16x8 Pk = pack8(s, s2);
#pragma unroll
            for (int dd = 0; dd < 2; ++dd) intra[dd] = mfma32(vfrag_perm_tr(Vh, loff, 32 * dd, 32 * kt + 16 * s2, h), Pk, intra[dd]); }
    }
    const float qdec = exp2f((float)(qrow + 1) * lg);
    float sum = 0.f;
#pragma unroll
    for (int dd = 0; dd < 2; ++dd)
#pragma unroll
        for (int i = 0; i < 16; ++i) { const float o = intra[dd][i] + qdec * cross[dd][i]; intra[dd][i] = o; sum += o; }
    sum += shx(sum, 32);
    const float mu = sum * (1.0f / 64.0f); float var = 0.f;
#pragma unroll
    for (int dd = 0; dd < 2; ++dd)
#pragma unroll
        for (int i = 0; i < 16; ++i) { const float d = intra[dd][i] - mu; intra[dd][i] = d; var += d * d; }
    var += shx(var, 32);
    const float rs = rsqrtf(var * (1.0f / 64.0f) + NORM_EPS);
#pragma unroll
    for (int dd = 0; dd < 2; ++dd)
#pragma unroll
        for (int g = 0; g < 4; ++g) { const int col = head * 64 + 32 * dd + 8 * g + 4 * h; const f32x4 gg = *(const f32x4*)(gcn + col);
            const u32x2 gt = *(const u32x2*)(PROJ + token * PW + C_GC + col);
            const float g0 = bf2f((unsigned short)(gt.x & 0xffffu)), g1 = bf2f((unsigned short)(gt.x >> 16)), g2 = bf2f((unsigned short)(gt.y & 0xffffu)), g3 = bf2f((unsigned short)(gt.y >> 16));
            const float o0 = intra[dd][4 * g] * rs * gg[0] * (g0 / (1.0f + __expf(-g0))), o1 = intra[dd][4 * g + 1] * rs * gg[1] * (g1 / (1.0f + __expf(-g1)));
            const float o2 = intra[dd][4 * g + 2] * rs * gg[2] * (g2 / (1.0f + __expf(-g2))), o3 = intra[dd][4 * g + 3] * rs * gg[3] * (g3 / (1.0f + __expf(-g3)));
            u32x2 w; w.x = pk2(o0, o1); w.y = pk2(o2, o3);
            if (n == 0 && qrow == 0) { const f32x4 ex = *(const f32x4*)(toutc + b * 384 + col); w.x = pk2(ex[0], ex[1]); w.y = pk2(ex[2], ex[3]); }
            *(u32x2*)(MIXED + token * D_MODEL + 640 + col) = w; }
}

constexpr size_t WS_T0 = 103 * MiB;
constexpr int T0_XM = 16384, T0_PROJ = 24576, T0_Y1 = 49152, T0_Y2 = 57344, T0_HT = 65536, T0_OUTC = 98304, T0_Y2P = 101376;
template <int KN> DI float t0_gemv16(const float* W, int N, int n0, const float* inT, ldsp redb, int tid) {
    const int cl = tid & 3, ks = tid >> 2;
    float acc[8][4];
#pragma unroll
    for (int r = 0; r < 8; ++r)
#pragma unroll
        for (int c = 0; c < 4; ++c) acc[r][c] = 0.f;
    const float* wp = W + (size_t)(ks * KN) * N + n0 + 4 * cl; const float* ip = inT + (size_t)(ks * KN) * 8;
#pragma unroll
    for (int k0 = 0; k0 < KN; k0 += 8) {
        f32x4 w[8];
#pragma unroll
        for (int k = 0; k < 8; ++k) w[k] = *(const f32x4*)(wp + (size_t)(k0 + k) * N);
#pragma unroll
        for (int k = 0; k < 8; ++k) { const f32x4 i0 = *(const f32x4*)(ip + (k0 + k) * 8), i1 = *(const f32x4*)(ip + (k0 + k) * 8 + 4);
#pragma unroll
            for (int r = 0; r < 4; ++r)
#pragma unroll
                for (int c = 0; c < 4; ++c) { acc[r][c] += i0[r] * w[k][c]; acc[4 + r][c] += i1[r] * w[k][c]; } } }
    LAS float* red = (LAS float*)redb;
#pragma unroll
    for (int r = 0; r < 8; ++r) *(LAS f32x4*)(red + (ks * 4 + cl) * 32 + r * 4) = (f32x4){acc[r][0], acc[r][1], acc[r][2], acc[r][3]};
    __syncthreads();
    float s = 0.f;
    if (tid < 128) { const int r = tid >> 4, c = tid & 15;
#pragma unroll 16
        for (int j = 0; j < 128; ++j) s += red[(j * 4 + (c >> 2)) * 32 + r * 4 + (c & 3)]; }
    __syncthreads();
    return s;
}
DI void t0_load_row(const float* p, int lane, f32x4 (&x)[4]) {
#pragma unroll
    for (int j = 0; j < 4; ++j) x[j] = *((const f32x4*)p + lane + 64 * j); }
DI float t0_ssq(const f32x4 (&x)[4]) { float s = 0.f;
#pragma unroll
    for (int j = 0; j < 4; ++j) s += (x[j][0] * x[j][0] + x[j][1] * x[j][1]) + (x[j][2] * x[j][2] + x[j][3] * x[j][3]);
    return wave_sum(s); }
DI void t0_put_inT(LAS float* inT, const f32x4 (&x)[4], const float* g, int lane, int r) {
#pragma unroll
    for (int j = 0; j < 4; ++j) { const f32x4 gg = *((const f32x4*)g + lane + 64 * j);
#pragma unroll
        for (int e = 0; e < 4; ++e) inT[(lane * 4 + 256 * j + e) * 8 + r] = x[j][e] * gg[e]; } }
DI void t0_store_row(float* p, int lane, const f32x4 (&x)[4]) {
#pragma unroll
    for (int j = 0; j < 4; ++j) *((f32x4*)p + lane + 64 * j) = x[j]; }
DI void t0_stage1(unsigned char* ldsg, unsigned char* ws, int l, int tb, const float* xin, const float* w_in_l, const float* g_post_prev, const float* g_pre, int tid) {
    tid = launder(tid);
    float* T = (float*)(ws + WS_T0); const int r = tid >> 6, lane = tid & 63;
    LAS float* inT = (LAS float*)(ldsp)ldsg; LAS float* rs = (LAS float*)((ldsp)ldsg + 98304);
    f32x4 x[4];
    if (l == 0) t0_load_row(xin + (size_t)r * SEQ * D_MODEL, lane, x);
    else { f32x4 y[4], y1[4]; t0_load_row(T + T0_XM + r * 1024, lane, x);
        t0_load_row(T + T0_Y2P + r * 1024, lane, y); t0_load_row(T + T0_Y2P + 8192 + r * 1024, lane, y1);
#pragma unroll
        for (int j = 0; j < 4; ++j) y[j] = y[j] + y1[j];
        t0_load_row(T + T0_Y2P + 16384 + r * 1024, lane, y1);
#pragma unroll
        for (int j = 0; j < 4; ++j) y[j] = y[j] + y1[j];
        t0_load_row(T + T0_Y2P + 24576 + r * 1024, lane, y1);
#pragma unroll
        for (int j = 0; j < 4; ++j) y[j] = y[j] + y1[j];
        const float rstd = rsqrtf(t0_ssq(y) * (1.0f / D_MODEL) + NORM_EPS);
#pragma unroll
        for (int j = 0; j < 4; ++j) x[j] = x[j] + y[j] * rstd * *((const f32x4*)g_post_prev + lane + 64 * j); }
    const float rstdx = rsqrtf(t0_ssq(x) * (1.0f / D_MODEL) + NORM_EPS);
    if (lane == 0) rs[r] = rstdx;
    t0_put_inT(inT, x, g_pre, lane, r);
    if (tb == 0) t0_store_row(T + (l & 1) * 8192 + r * 1024, lane, x);
    __syncthreads();
    const float s = t0_gemv16<8>(w_in_l, IN_W, 16 * tb, (const float*)ldsg, (ldsp)ldsg + 32768, tid);
    if (tid < 128) T[T0_PROJ + (tid >> 4) * 3072 + 16 * tb + (tid & 15)] = s * rs[tid >> 4];
    __syncthreads();
}
DI void t0_stage2(unsigned char* ldsg, unsigned char* ws, int l, int tb, const float* w_out_l, const float* sinks_l, const float* bg, const float* rope_c, const float* rope_s, int tid) {
    tid = launder(tid);
    float* T = (float*)(ws + WS_T0); const int r = tid >> 6, lane = tid & 63;
    LAS float* inT = (LAS float*)(ldsp)ldsg; const float* P = T + T0_PROJ + r * 3072;
    const float cc = rope_c[lane & 31], ss = rope_s[lane & 31];
#define T0_ROPE(v, dst) { const float v_ = (v), o_ = shx(v_, 32); dst = (lane < 32) ? (v_ * cc - o_ * ss) : (o_ * ss + v_ * cc); }
    float outa[6]; float ssqA = 0.f;
#pragma unroll
    for (int kv = 0; kv < 2; ++kv) { float ka; T0_ROPE(P[C_KA + kv * 64 + lane], ka); const float va = P[C_VA + kv * 64 + lane];
#pragma unroll
        for (int g = 0; g < 3; ++g) { const int h = 3 * kv + g; float qa; T0_ROPE(P[C_QA + h * 64 + lane], qa);
            const float sc = wave_sum(qa * ka) * 0.125f, sink = sinks_l[h], mx = fmaxf(sc, sink), e1 = expf(sc - mx), e2 = expf(sink - mx);
            outa[h] = (e1 / (e1 + e2)) * va; ssqA += outa[h] * outa[h]; } }
    const float rstdA = rsqrtf(wave_sum(ssqA) * (1.0f / 384.0f) + NORM_EPS);
#pragma unroll
    for (int h = 0; h < 6; ++h) inT[(h * 64 + lane) * 8 + r] = outa[h] * rstdA * bg[h * 64 + lane];
#pragma unroll
    for (int h = 0; h < 4; ++h) inT[(384 + h * 64 + lane) * 8 + r] = 0.f;
#pragma unroll
    for (int h = 0; h < 6; ++h) { float qc, kc; T0_ROPE(P[C_QC + h * 64 + lane], qc); T0_ROPE(P[C_KC + h * 64 + lane], kc);
        const float c = wave_sum(qc * kc) * 0.125f, o = c * P[C_VC + h * 64 + lane], mu = wave_sum(o) * (1.0f / 64.0f), d = o - mu, var = wave_sum(d * d) * (1.0f / 64.0f);
        const float gt = P[C_GC + h * 64 + lane], oc = d * rsqrtf(var + NORM_EPS) * bg[640 + h * 64 + lane] * (gt / (1.0f + expf(-gt)));
        inT[(640 + h * 64 + lane) * 8 + r] = oc;
        if (tb == 0) T[T0_OUTC + r * 384 + h * 64 + lane] = oc; }
#undef T0_ROPE
    __syncthreads();
    const float s = t0_gemv16<8>(w_out_l, D_MODEL, 16 * tb, (const float*)ldsg, (ldsp)ldsg + 32768, tid);
    if (tid < 128) T[T0_Y1 + (tid >> 4) * 1024 + 16 * tb + (tid & 15)] = s;
    __syncthreads();
}
DI void t0_stage3(unsigned char* ldsg, unsigned char* ws, int l, int tb, const float* w_up_l, const float* g_post, const float* g_pre, int tid) {
    tid = launder(tid);
    float* T = (float*)(ws + WS_T0); const int r = tid >> 6, lane = tid & 63;
    LAS float* inT = (LAS float*)(ldsp)ldsg; LAS float* rs = (LAS float*)((ldsp)ldsg + 98304);
    f32x4 x[4], y[4]; t0_load_row(T + (l & 1) * 8192 + r * 1024, lane, x); t0_load_row(T + T0_Y1 + r * 1024, lane, y);
    const float rstd = rsqrtf(t0_ssq(y) * (1.0f / D_MODEL) + NORM_EPS);
#pragma unroll
    for (int j = 0; j < 4; ++j) x[j] = x[j] + y[j] * rstd * *((const f32x4*)g_post + lane + 64 * j);
    const float rstdx = rsqrtf(t0_ssq(x) * (1.0f / D_MODEL) + NORM_EPS);
    if (lane == 0) rs[r] = rstdx;
    t0_put_inT(inT, x, g_pre, lane, r);
    if (tb == 0) t0_store_row(T + T0_XM + r * 1024, lane, x);
    __syncthreads();
    const float s = t0_gemv16<8>(w_up_l, D_FF, 16 * tb, (const float*)ldsg, (ldsp)ldsg + 32768, tid);
    if (tid < 128) { const float v = fmaxf(s * rs[tid >> 4], 0.f); T[T0_HT + (16 * tb + (tid & 15)) * 8 + (tid >> 4)] = v * v; }
    __syncthreads();
}
DI void t0_stage4(unsigned char* ldsg, unsigned char* ws, int tb, const float* w_down_l, int tid) {
    tid = launder(tid);
    float* T = (float*)(ws + WS_T0);
    const int cb = tb & 63, kq = tb >> 6;
    const float s = t0_gemv16<8>(w_down_l + (size_t)kq * 1024 * D_MODEL, D_MODEL, 16 * cb, T + T0_HT + kq * 8192, (ldsp)ldsg + 32768, tid);
    if (tid < 128) T[T0_Y2P + kq * 8192 + (tid >> 4) * 1024 + 16 * cb + (tid & 15)] = s;
    __syncthreads();
}

DI f32x4 unpk4(u32x2 w) { f32x4 r; r[0] = __uint_as_float(w.x << 16); r[1] = __uint_as_float(w.x & 0xffff0000u); r[2] = __uint_as_float(w.y << 16); r[3] = __uint_as_float(w.y & 0xffff0000u); return r; }
template <bool SRC_BF, bool DST_BF>
DI void norm_res_phase(const void* xsrc_, const bf16_t* Y, const float* gpost, const float* gpre, void* xout_, bf16_t* XN, int tid, int bid) {
    constexpr int NR = 4;
    const int wave = tid >> 6, lane = tid & 63, NW = gridDim.x * NWAVES;
    for (int row0 = bid * NWAVES + wave; row0 < M_TOK; row0 += NR * NW) {
        f32x4 xf[SRC_BF ? 1 : NR][4]; u32x2 xraw[SRC_BF ? NR : 1][4]; u32x2 yraw[NR][4];
#pragma unroll
        for (int r = 0; r < NR; ++r) { const size_t row = (size_t)row0 + (size_t)r * NW;
            if (SRC_BF) { const u32x2* xr = (const u32x2*)((const bf16_t*)xsrc_ + row * D_MODEL) + lane;
#pragma unroll
                for (int j = 0; j < 4; ++j) xraw[SRC_BF ? r : 0][j] = xr[64 * j];
            } else { const f32x4* xr = (const f32x4*)((const float*)xsrc_ + row * D_MODEL) + lane;
#pragma unroll
                for (int j = 0; j < 4; ++j) xf[SRC_BF ? 0 : r][j] = xr[64 * j]; }
            if (Y) { const u32x2* yr = (const u32x2*)(Y + row * D_MODEL) + lane;
#pragma unroll
                for (int j = 0; j < 4; ++j) yraw[r][j] = yr[64 * j]; } }
        f32x4 gp[4], gq[4];
        if (Y) {
#pragma unroll
            for (int j = 0; j < 4; ++j) gp[j] = *((const f32x4*)gpost + lane + 64 * j); }
        if (XN) {
#pragma unroll
            for (int j = 0; j < 4; ++j) gq[j] = *((const f32x4*)gpre + lane + 64 * j); }
#pragma unroll
        for (int r = 0; r < NR; ++r) { const size_t row = (size_t)row0 + (size_t)r * NW;
            f32x4 v[4];
#pragma unroll
            for (int j = 0; j < 4; ++j) v[j] = SRC_BF ? unpk4(xraw[SRC_BF ? r : 0][j]) : xf[SRC_BF ? 0 : r][j];
            if (Y) { f32x4 y[4]; float s = 0.f;
#pragma unroll
                for (int j = 0; j < 4; ++j) { y[j] = unpk4(yraw[r][j]); s += (y[j][0] * y[j][0] + y[j][1] * y[j][1]) + (y[j][2] * y[j][2] + y[j][3] * y[j][3]); }
                const float rstd = rsqrtf(wave_sum(s) * (1.0f / D_MODEL) + NORM_EPS);
#pragma unroll
                for (int j = 0; j < 4; ++j) v[j] = v[j] + y[j] * rstd * gp[j]; }
            if (xout_) {
                if (DST_BF) { u32x2* xo = (u32x2*)((bf16_t*)xout_ + row * D_MODEL) + lane;
#pragma unroll
                    for (int j = 0; j < 4; ++j) { u32x2 w; w.x = pk2(v[j][0], v[j][1]); w.y = pk2(v[j][2], v[j][3]); xo[64 * j] = w;
                        v[j] = unpk4(w); }
                } else { f32x4* xo = (f32x4*)((float*)xout_ + row * D_MODEL) + lane;
#pragma unroll
                    for (int j = 0; j < 4; ++j) xo[64 * j] = v[j]; } }
            if (XN) { float s = 0.f;
#pragma unroll
                for (int j = 0; j < 4; ++j) s += (v[j][0] * v[j][0] + v[j][1] * v[j][1]) + (v[j][2] * v[j][2] + v[j][3] * v[j][3]);
                const float rstd = rsqrtf(wave_sum(s) * (1.0f / D_MODEL) + NORM_EPS);
                u32x2* xo = (u32x2*)(XN + row * D_MODEL) + lane;
#pragma unroll
                for (int j = 0; j < 4; ++j) { const f32x4 o = v[j] * rstd * gq[j]; u32x2 w; w.x = pk2(o[0], o[1]); w.y = pk2(o[2], o[3]); xo[64 * j] = w; } }
        }
    }
}
template <int MODE> DI void transpose_item(const float* W, int K, int Nsrc, int Ndst, bf16_t* WT, LAS float* scr, int item, int lane, const float* gk) {
    const int nblk = Ndst / 32, kb = item / nblk, nbk = item % nblk, k0 = 64 * kb, n0 = 32 * nbk;
    const int nd = n0 + (lane & 31); int src = nd; float sc = 1.f; bool ok = true;
    if (MODE == 1) { const int head = nd >> 6, p = nd & 63; const bool rope = (head < 8) || (head >= 22 && head < 34);
        const int f = rope ? (4 * (p >> 3) + (p & 3) + 32 * ((p >> 2) & 1)) : p; ok = nd < IN_W; src = ok ? head * 64 + f : 0;
        sc = ((head < 6) || (head >= 10 && head < 14) || (head >= 28 && head < 34)) ? 0.125f : 1.f; }
#pragma unroll
    for (int i = 0; i < 32; ++i) { const int kk = 2 * i + (lane >> 5); scr[kk * 33 + (lane & 31)] = ok ? W[(size_t)(k0 + kk) * Nsrc + src] * (gk ? sc * gk[k0 + kk] : sc) : 0.f; }
    LDS_WAIT();
    const int c = lane & 7;
#pragma unroll
    for (int j = 0; j < 4; ++j) { const int n = (lane >> 3) + 8 * j; const LAS float* s = scr + (8 * c) * 33 + n;
        u32x4 o; o.x = pk2(s[0 * 33], s[1 * 33]); o.y = pk2(s[2 * 33], s[3 * 33]); o.z = pk2(s[4 * 33], s[5 * 33]); o.w = pk2(s[6 * 33], s[7 * 33]);
        *(u32x4*)(WT + (size_t)(n0 + n) * K + k0 + 8 * c) = o; }
    LDS_WAIT();
}

#ifdef DUP_MIX
#define MIXREP 2
#else
#define MIXREP 1
#endif
#ifdef DUP_P2
#define MIXREP2 2
#else
#define MIXREP2 MIXREP
#endif
struct Args { const float* x; const int* positions; const float* w_in; const float* w_out; const float* sinks; const float* branch_gain; const float* w_up; const float* w_down;
              const float* g_mix_pre; const float* g_mix_post; const float* g_mlp_pre; const float* g_mlp_post; float* out; unsigned char* ws; int ph_lo, ph_hi; };

__global__ void __launch_bounds__(NTHREADS, 2) fwd_kernel(Args a) {
    extern __shared__ __attribute__((aligned(16))) unsigned char lds_raw[];
    ldsp lds = (ldsp)lds_raw;
    cg::grid_group grid = cg::this_grid();
    const int G = gridDim.x;
    unsigned char* ws = a.ws;
    float* ROPE_C = (float*)(ws + WS_ROPE); float* ROPE_S = ROPE_C + SEQ * 32;
    bf16_t* XN = (bf16_t*)(ws + WS_XN); bf16_t* Y = (bf16_t*)(ws + WS_Y); bf16_t* PROJ = (bf16_t*)(ws + WS_PROJ); bf16_t* MIXED = (bf16_t*)(ws + WS_MIXED); bf16_t* H = (bf16_t*)(ws + WS_H); bf16_t* XB = (bf16_t*)(ws + WS_XB); float* PS1 = (float*)(ws + WS_PS1); float* PS2 = (float*)(ws + WS_PS2); unsigned* CNT = (unsigned*)(ws + WS_CNT);
    float* KV = (float*)(ws + WS_KV);
    volatile LAS unsigned* MISC = (volatile LAS unsigned*)(lds + 155392);
    if (threadIdx.x < 16) MISC[threadIdx.x] = 0u;
    __syncthreads();
    const XcdBarrier xbar = xcd_barrier_post((unsigned*)ws + 4096, MISC + 8);
    const int lo = a.ph_lo, hi = a.ph_hi;
    for (int ph = lo; ph < hi; ++ph) {
        int tid_l = threadIdx.x, bid_l = blockIdx.x; asm volatile("" : "+v"(tid_l)); asm volatile("" : "+s"(bid_l));
        const int tid = tid_l, bid = bid_l, wave = __builtin_amdgcn_readfirstlane(tid >> 6), lane = tid & 63;
        if (ph == 0) {
#ifdef DUP_P0
            for (int rep0_ = 0; rep0_ < 2; ++rep0_) {
#endif
            for (int idx = bid * NTHREADS + tid; idx < SEQ * 32; idx += G * NTHREADS) { const int s = idx >> 5, i = idx & 31;
                const float inv = powf(10000.0f, -(float)(2 * i) / 64.0f), ang = (float)a.positions[s] * inv; ROPE_C[idx] = cosf(ang); ROPE_S[idx] = sinf(ang); }
            LAS float* scr = (LAS float*)(lds + wave * 16384);
            constexpr int I_IN = 16 * 96, I_OUT = 16 * 32, I_UP = 16 * 128, I_DN = 64 * 32, I_L = I_IN + I_OUT + I_UP + I_DN;
            for (int it = bid * NWAVES + wave; it < DEPTH * I_L; it += G * NWAVES) {
                const int l = it / I_L; int r = it % I_L; unsigned char* wl = ws + WS_W + (size_t)l * W_LAYER;
                if (r < I_IN) { transpose_item<1>(a.w_in + (size_t)l * D_MODEL * IN_W, D_MODEL, IN_W, PW, (bf16_t*)wl, scr, r, lane, a.g_mix_pre + l * D_MODEL); continue; } r -= I_IN;
                if (r < I_OUT) { transpose_item<0>(a.w_out + (size_t)l * D_MODEL * D_MODEL, D_MODEL, D_MODEL, D_MODEL, (bf16_t*)(wl + W_OUT_OFF), scr, r, lane, nullptr); continue; } r -= I_OUT;
                if (r < I_UP) { transpose_item<0>(a.w_up + (size_t)l * D_MODEL * D_FF, D_MODEL, D_FF, D_FF, (bf16_t*)(wl + W_UP_OFF), scr, r, lane, a.g_mlp_pre + l * D_MODEL); continue; } r -= I_UP;
                transpose_item<0>(a.w_down + (size_t)l * D_FF * D_MODEL, D_FF, D_MODEL, D_MODEL, (bf16_t*)(wl + W_DOWN_OFF), scr, r, lane, nullptr);
            }
            for (int idx = bid * NTHREADS + tid; idx < DEPTH * 4 * D_MODEL; idx += G * NTHREADS) { const int l = idx >> 12, w = (idx >> 10) & 3, c = idx & 1023;
                const float* srcg = (w == 0) ? a.g_mix_pre : (w == 1) ? a.g_mix_post : (w == 2) ? a.g_mlp_pre : a.g_mlp_post; ((float*)(ws + WS_GAIN))[idx] = srcg[l * D_MODEL + c]; }
            for (int row0 = bid * NWAVES + wave; row0 < M_TOK; row0 += 4 * G * NWAVES) {
                f32x4 v[4][4];
#pragma unroll
                for (int r = 0; r < 4; ++r) { const f32x4* xr = (const f32x4*)(a.x + ((size_t)row0 + (size_t)r * G * NWAVES) * D_MODEL) + lane;
#pragma unroll
                    for (int j = 0; j < 4; ++j) v[r][j] = xr[64 * j]; }
#pragma unroll
                for (int r = 0; r < 4; ++r) { const size_t row = (size_t)row0 + (size_t)r * G * NWAVES; float s = 0.f;
#pragma unroll
                    for (int j = 0; j < 4; ++j) s += (v[r][j][0] * v[r][j][0] + v[r][j][1] * v[r][j][1]) + (v[r][j][2] * v[r][j][2] + v[r][j][3] * v[r][j][3]);
#pragma unroll
                    for (int j = 0; j < 4; ++j) { u32x2 wb; wb.x = pk2(v[r][j][0], v[r][j][1]); wb.y = pk2(v[r][j][2], v[r][j][3]); ((u32x2*)(XB + row * D_MODEL) + lane)[64 * j] = wb; }
                    s = wave_sum(s);
                    if (lane == 0) *(f32x4*)(PS2 + row * 4) = (f32x4){s, 0.f, 0.f, 0.f}; }
            }
            __syncthreads();
#ifdef DUP_P0
            }
#endif
        } else {
            const int l = (ph - 1) / 7, k = (ph - 1) % 7;
            unsigned char* wl = ws + WS_W + (size_t)l * W_LAYER;
            const float* bg = a.branch_gain + l * D_MODEL;
            if (k == 0 && bid < 184) t0_stage1(lds_raw, ws, l, bid, a.x, a.w_in + (size_t)l * D_MODEL * IN_W, a.g_mlp_post + (l > 0 ? l - 1 : 0) * D_MODEL, a.g_mix_pre + l * D_MODEL, tid);
            if (k == 1 && bid >= 192) t0_stage2(lds_raw, ws, l, bid - 192, a.w_out + (size_t)l * D_MODEL * D_MODEL, a.sinks + l * 6, bg, ROPE_C, ROPE_S, tid);
            if (k == 2) t0_stage3(lds_raw, ws, l, bid, a.w_up + (size_t)l * D_MODEL * D_FF, a.g_mix_post + l * D_MODEL, a.g_mlp_pre + l * D_MODEL, tid);
            if (k == 3 && bid < 256) t0_stage4(lds_raw, ws, bid, a.w_down + (size_t)l * D_FF * D_MODEL, tid);
            if (k == 0 || k >= 4) {
                const bf16_t* A = XB; const bf16_t* Bt = (const bf16_t*)wl; int N = PW, K = D_MODEL;
                int mode = 2;
                if (k == 4) { A = MIXED; Bt = (const bf16_t*)(wl + W_OUT_OFF); N = D_MODEL; mode = 3; }
                if (k == 5) { Bt = (const bf16_t*)(wl + W_UP_OFF); N = D_FF; mode = 1; }
                if (k == 6) { A = H; Bt = (const bf16_t*)(wl + W_DOWN_OFF); N = D_MODEL; K = D_FF; mode = 4; }
                pg8::EpiAny E{ws, a.x, a.out, mode, l};
                pg8::Gemm g{A, Bt, M_TOK, N, K}; pg8::StaticOrder S; S.init(M_TOK, N, G, bid);
                pg8::gemm_phase<pg8::EpiAny, pg8::StaticOrder, PG8_ALIGN, PG8_SP2>(lds, g, S, E, tid);
            } else if (k == 1) {
                int u_ = (G == 256) ? ((bid & 7) * 32 + (bid >> 3)) : bid;
                for (; u_ < 512; u_ += G) swa_unit(lds, u_, PROJ, MIXED, a.sinks + l * 6, bg, tid);
                {
                    const int tl = launder(tid);
                    u32x4 pre[4][2];
#pragma unroll
                    for (int t_ = 0; t_ < 4; ++t_) { pre[t_][0] = (u32x4){0u, 0u, 0u, 0u}; pre[t_][1] = (u32x4){0u, 0u, 0u, 0u}; }
                    if (u_ < 2048) ret_kv_load(pre, u_ - 512, PROJ, tl);
                    for (; u_ < 2048; u_ += G) {
                        __syncthreads();
                        ret_kv_unit(lds, u_ - 512, pre, KV, tl);
                        __syncthreads();
                        if (u_ + G < 2048) ret_kv_load(pre, u_ + G - 512, PROJ, tl);
                        ret_kv_compute(lds, u_ - 512, KV, tl);
                    }
                }
                __syncthreads();
            } else if (k == 2) {
                ret_scan_phase(KV, tid, bid);
            } else {
                for (int u_ = (G == 256) ? ((bid & 7) * 32 + (bid >> 3)) : bid; u_ < 2048; u_ += G) { const int u = u_;
                    if (u < 512) sb_unit(lds, u, PROJ, MIXED, bg + 384, tid);
                    else ret_out_unit(lds, u - 512, PROJ, KV, MIXED, bg + 640, tid, (const float*)(ws + WS_T0) + T0_OUTC);
                }
                __syncthreads();
            }
        }
        if (ph + 1 < hi) { if (ph == lo) grid.sync(); else xcd_barrier(xbar); }
    }
}

extern "C" void kernel_launch(void* const* d_in, const int* in_sizes, int n_in, void* d_out, int out_size, void* d_ws, size_t ws_size, hipStream_t stream) {
    static int grid = 0;
    if (grid == 0) {
        if (n_in != 12 || in_sizes[0] != M_TOK * D_MODEL || out_size != M_TOK * D_MODEL || ws_size < WS_END) { fprintf(stderr, "kernel_launch: unexpected shapes (n_in %d in0 %d out %d ws %zu)\n", n_in, n_in > 0 ? in_sizes[0] : -1, out_size, ws_size); grid = -1; return; }
        int dev = 0, cus = 0, per_cu = 0;
        if (hipGetDevice(&dev) != hipSuccess || hipDeviceGetAttribute(&cus, hipDeviceAttributeMultiprocessorCount, dev) != hipSuccess) { grid = -1; return; }
        if (hipFuncSetAttribute((const void*)fwd_kernel, hipFuncAttributeMaxDynamicSharedMemorySize, LDS_BYTES) != hipSuccess) { fprintf(stderr, "kernel_launch: hipFuncSetAttribute failed\n"); grid = -1; return; }
        if (hipOccupancyMaxActiveBlocksPerMultiprocessor(&per_cu, (const void*)fwd_kernel, NTHREADS, LDS_BYTES) != hipSuccess || per_cu < 1) fprintf(stderr, "kernel_launch: occupancy query reports %d\n", per_cu);
        (void)hipGetLastError();
        grid = cus;
    }
    if (grid < 0) return;
    if (hipMemsetAsync(d_ws, 0, 262144, stream) != hipSuccess) { fprintf(stderr, "kernel_launch: memset of the barrier words failed\n"); return; }
    Args a{};
    a.x = (const float*)d_in[0]; a.positions = (const int*)d_in[1]; a.w_in = (const float*)d_in[2]; a.w_out = (const float*)d_in[3]; a.sinks = (const float*)d_in[4]; a.branch_gain = (const float*)d_in[5];
    a.w_up = (const float*)d_in[6]; a.w_down = (const float*)d_in[7]; a.g_mix_pre = (const float*)d_in[8]; a.g_mix_post = (const float*)d_in[9]; a.g_mlp_pre = (const float*)d_in[10]; a.g_mlp_post = (const float*)d_in[11];
    a.out = (float*)d_out; a.ws = (unsigned char*)d_ws; a.ph_lo = 0; a.ph_hi = 1 + 7 * DEPTH;
    void* args[] = {&a};
    hipError_t e = hipLaunchCooperativeKernel((const void*)fwd_kernel, dim3(grid), dim3(NTHREADS), args, LDS_BYTES, stream);
    if (e != hipSuccess) fprintf(stderr, "kernel_launch: cooperative launch failed: %s (grid %d)\n", hipGetErrorString(e), grid);
}
```

```cpp
#include <hip/hip_runtime.h>
#include <hip/hip_cooperative_groups.h>
#include <cstdio>
#include <cstdint>
namespace cg = cooperative_groups;
#define PG8_SP2 true
#define PG8_ALIGN true
constexpr int D_MODEL = 1024, BATCH = 8, SEQ = 8192, DEPTH = 4, M_TOK = BATCH * SEQ, D_FF = 4096;
constexpr int IN_W = 2944, PW = 3072;
constexpr int C_QA = 0, C_KA = 384, C_VA = 512, C_QB = 640, C_KB = 896, C_VB = 1152, C_QC = 1408, C_KC = 1792, C_VC = 2176, C_GC = 2560;
constexpr float NORM_EPS = 1e-6f;
constexpr float SB_THR = -36.0f;
constexpr int NWAVES = 8, NTHREADS = 512;
constexpr int LDS_BYTES = 155648;
constexpr size_t MiB = 1u << 20;
constexpr size_t WS_ROPE = 1 * MiB;
constexpr size_t WS_W = 4 * MiB;
constexpr size_t W_LAYER = 24 * MiB, W_OUT_OFF = 6 * MiB, W_UP_OFF = 8 * MiB, W_DOWN_OFF = 16 * MiB;
constexpr size_t WS_CNT = 65536;
constexpr size_t WS_PS1 = 100 * MiB;
constexpr size_t WS_PS2 = 101 * MiB;
constexpr size_t WS_GAIN = 102 * MiB;
constexpr size_t WS_XN = 104 * MiB;
constexpr size_t WS_MIXED = 232 * MiB;
constexpr size_t WS_Y = 232 * MiB;
constexpr size_t WS_H = 360 * MiB;
constexpr size_t WS_PROJ = 360 * MiB;
constexpr size_t WS_KV = 744 * MiB;
constexpr size_t WS_XB = 872 * MiB;
constexpr size_t WS_END = 1000 * MiB;

__device__ __forceinline__ float shx(float v, int msk) { int l = __builtin_amdgcn_mbcnt_hi(~0u, __builtin_amdgcn_mbcnt_lo(~0u, 0u)); asm volatile("" : "+v"(l)); return __int_as_float(__builtin_amdgcn_ds_bpermute((l ^ msk) << 2, __float_as_int(v))); }
namespace pg8 {
#define PG8_LAS __attribute__((address_space(3)))
typedef unsigned short bf16_t;
typedef short bf16x8 __attribute__((ext_vector_type(8)));
typedef float f32x4 __attribute__((ext_vector_type(4)));
typedef unsigned u32x4 __attribute__((ext_vector_type(4)));
constexpr int BM = 256, BK = 64, HALF = 128, HTB = HALF * BK * 2  , STAGE_BYTES = 8 * HTB, NXCD = 8, WGM = 8;

__host__ __device__ __forceinline__ int lds_byte(int r, int c) { const int st = (r >> 4) * 2 + (c >> 5), rr = r & 15, cc = c & 31, ob = rr * 64 + cc * 2; return st * 1024 + (ob ^ (((ob >> 9) & 1) << 5)); }
__host__ __device__ __forceinline__ void stage_rc(int b, int& R, int& C) { const int st = b / 1024, sb = b % 1024, swz = sb ^ (((sb >> 9) & 1) << 5); R = (st >> 1) * 16 + swz / 64; C = (st & 1) * 32 + (swz % 64) / 2; }
__host__ __device__ __forceinline__ int perm32(int rho) { const int n = rho >> 4, i = rho & 15; return 8 * (i >> 2) + 4 * n + (i & 3); }

struct Unit { int pm, pn; };
struct Gemm { const bf16_t* A; const bf16_t* Bt; int M, N, K; };

struct StaticOrder {
    int nM, nN, nwg, G, c;
    __host__ __device__ void init(int M, int N, int G_, int c_) { nM = M / BM; nN = N / BM; nwg = nM * nN; G = G_; c = c_; }
    __host__ __device__ bool next(int i, Unit& u) const {
        const long L = (long)i * G + c; if (L >= nwg) return false;
        int wgid = (int)L; { const int q = nwg / NXCD, r = nwg % NXCD, xcd = wgid % NXCD, off = wgid / NXCD; wgid = (xcd < r ? xcd * (q + 1) : r * (q + 1) + (xcd - r) * q) + off; }
        const int nig = WGM * nN, gid = wgid / nig, fm = gid * WGM, gsz = (nM - fm) < WGM ? (nM - fm) : WGM;
        u.pm = fm + ((wgid % nig) % gsz); u.pn = (wgid % nig) / gsz; return true;
    }
    __device__ __forceinline__ void a_ready(const Unit&) const {}
    __device__ __forceinline__ void done(const Unit&) const {}
};
typedef __bf16 bf16v2_t __attribute__((ext_vector_type(2)));
typedef float f32v2_t __attribute__((ext_vector_type(2)));
typedef unsigned u32x2 __attribute__((ext_vector_type(2)));
__device__ __forceinline__ unsigned pk2(float lo, float hi) { f32v2_t v = {lo, hi}; bf16v2_t b = __builtin_convertvector(v, bf16v2_t); return __builtin_bit_cast(unsigned, b); }
template <int ACT> struct EpiPlain {
    static constexpr bool PERM = true, AFTER_DRAIN = false;
    bf16_t* O; int ldc;
    __device__ __forceinline__ void operator()(const f32x4 (&acc)[2][2][4][2], const Unit& u, int wr, int wc, int fr, int fq) const {
        const int row0 = u.pm * BM + wr * 64 + fr, col0 = u.pn * BM + wc * 32 + 8 * fq;
#pragma unroll
        for (int ai = 0; ai < 2; ++ai)
#pragma unroll
            for (int m = 0; m < 4; ++m) { bf16_t* rowp = O + (size_t)(row0 + ai * HALF + m * 16) * ldc + col0;
#pragma unroll
                for (int bj = 0; bj < 2; ++bj) { f32x4 v0 = acc[ai][bj][m][0], v1 = acc[ai][bj][m][1];
                    if (ACT == 1) {
#pragma unroll
                        for (int j = 0; j < 4; ++j) { const float a = fmaxf(v0[j], 0.f), b = fmaxf(v1[j], 0.f); v0[j] = a * a; v1[j] = b * b; } }
                    u32x4 w; w.x = pk2(v0[0], v0[1]); w.y = pk2(v0[2], v0[3]); w.z = pk2(v1[0], v1[1]); w.w = pk2(v1[2], v1[3]);
                    *(u32x4*)(rowp + bj * HALF) = w; } }
    }
};
struct EpiRope {
    static constexpr bool PERM = true, AFTER_DRAIN = false;
    bf16_t* O; int ldc; const float* cs; const float* sn; int seq_mask;
    __device__ __forceinline__ void operator()(const f32x4 (&acc)[2][2][4][2], const Unit& u, int wr, int wc, int fr, int fq) const {
        const int row0 = u.pm * BM + wr * 64 + fr, col0 = u.pn * BM + wc * 32 + 8 * fq;
        const int ci = 4 * (wc & 1) + fq;
        bool rope[2];
#pragma unroll
        for (int bj = 0; bj < 2; ++bj) { const int head = 4 * u.pn + 2 * bj + (wc >> 1); rope[bj] = (head < 8) || (head >= 22 && head < 34); }
        const bool anyrope = rope[0] || rope[1];
#pragma unroll
        for (int ai = 0; ai < 2; ++ai)
#pragma unroll
            for (int m = 0; m < 4; ++m) { const int row = row0 + ai * HALF + m * 16; bf16_t* rowp = O + (size_t)row * ldc + col0;
                f32x4 c4 = {1.f, 1.f, 1.f, 1.f}, s4 = {0.f, 0.f, 0.f, 0.f};
                if (anyrope) { const int s = row & seq_mask; c4 = *(const f32x4*)(cs + s * 32 + 4 * ci); s4 = *(const f32x4*)(sn + s * 32 + 4 * ci); }
#pragma unroll
                for (int bj = 0; bj < 2; ++bj) { f32x4 v0 = acc[ai][bj][m][0], v1 = acc[ai][bj][m][1];
                    if (rope[bj]) { const f32x4 y0 = v0 * c4 - v1 * s4, y1 = v0 * s4 + v1 * c4; v0 = y0; v1 = y1; }
                    u32x4 w; w.x = pk2(v0[0], v0[1]); w.y = pk2(v0[2], v0[3]); w.z = pk2(v1[0], v1[1]); w.w = pk2(v1[2], v1[3]);
                    *(u32x4*)(rowp + bj * HALF) = w; } }
    }
};

#define PG8_RLX_AGENT __ATOMIC_RELAXED, __HIP_MEMORY_SCOPE_AGENT
struct EpiAny {
    static constexpr bool PERM = true, AFTER_DRAIN = false;
    unsigned char* ws; const float* xin; float* outp; int mode; int l;
    __device__ __forceinline__ void prime(int pm, PG8_LAS unsigned char* lds, int tid) const {
        if (mode >= 3) return;
        if (tid < 256) { const f32x4 p = *(const f32x4*)((const float*)(ws + WS_PS2) + (size_t)(pm * BM + tid) * 4);
            ((PG8_LAS float*)(lds + 140288))[tid] = rsqrtf(((p[0] + p[1]) + (p[2] + p[3])) * (1.0f / 1024.0f) + NORM_EPS); }
    }
    __device__ __forceinline__ void operator()(const f32x4 (&acc)[2][2][4][2], const Unit& u, int wr, int wc, int fr, int fq, PG8_LAS unsigned char* lds, int wid, int lane, int next_pm, int parity) const {
        asm volatile("" : "+v"(fr), "+v"(fq));
        if (mode >= 3) { fused(acc, u, wr, wc, fr, fq, lds, wid, lane); return; }
        bf16_t* O = (bf16_t*)(ws + (mode == 1 ? WS_H : WS_PROJ)); const int ldc = (mode == 1) ? D_FF : PW, seq_mask = SEQ - 1;
        const float* cs = (const float*)(ws + WS_ROPE); const float* sn = cs + SEQ * 32; const float* rowss = (const float*)(ws + WS_PS2); const float eps = NORM_EPS;
        PG8_LAS float* RSC = (PG8_LAS float*)(lds + 140288); const int tid = wid * 64 + lane;
        f32x4 pnext = {0.f, 0.f, 0.f, 0.f};
        if (tid < 256 && next_pm >= 0) pnext = *(const f32x4*)(rowss + (size_t)(next_pm * BM + tid) * 4);
        const int row0 = u.pm * BM + wr * 64 + fr, col0 = u.pn * BM + wc * 32 + 8 * fq;
        const int ci = 4 * (wc & 1) + fq;
        bool rope[2];
#pragma unroll
        for (int bj = 0; bj < 2; ++bj) { const int head = 4 * u.pn + 2 * bj + (wc >> 1); rope[bj] = (mode == 2) && ((head < 8) || (head >= 22 && head < 34)); }
        const bool anyrope = rope[0] || rope[1];
#pragma unroll
        for (int ai = 0; ai < 2; ++ai) {
            f32x4 c4[4], s4[4]; float rsc[4];
#pragma unroll
            for (int m = 0; m < 4; ++m) { c4[m] = (f32x4){1.f, 1.f, 1.f, 1.f}; s4[m] = (f32x4){0.f, 0.f, 0.f, 0.f}; rsc[m] = 1.f; }
#pragma unroll
            for (int m = 0; m < 4; ++m) rsc[m] = RSC[parity * 256 + ai * HALF + wr * 64 + m * 16 + fr];
            if (anyrope) {
#pragma unroll
                for (int m = 0; m < 4; ++m) { const int s = (row0 + ai * HALF + m * 16) & seq_mask; c4[m] = *(const f32x4*)(cs + s * 32 + 4 * ci); s4[m] = *(const f32x4*)(sn + s * 32 + 4 * ci); } }
#pragma unroll
            for (int m = 0; m < 4; ++m) { const int row = row0 + ai * HALF + m * 16; bf16_t* rowp = O + (size_t)row * ldc + col0;
#pragma unroll
                for (int bj = 0; bj < 2; ++bj) { f32x4 v0 = acc[ai][bj][m][0] * rsc[m], v1 = acc[ai][bj][m][1] * rsc[m];
                    if (rope[bj]) { const f32x4 y0 = v0 * c4[m] - v1 * s4[m], y1 = v0 * s4[m] + v1 * c4[m]; v0 = y0; v1 = y1; }
                    if (mode == 1) {
#pragma unroll
                        for (int j = 0; j < 4; ++j) { const float a = fmaxf(v0[j], 0.f), b = fmaxf(v1[j], 0.f); v0[j] = a * a; v1[j] = b * b; } }
                    u32x4 w; w.x = pk2(v0[0], v0[1]); w.y = pk2(v0[2], v0[3]); w.z = pk2(v1[0], v1[1]); w.w = pk2(v1[2], v1[3]);
                    *(u32x4*)(rowp + bj * HALF) = w; } }
            asm volatile("" ::: "memory");
        }
        if (tid < 256 && next_pm >= 0) RSC[(parity ^ 1) * 256 + tid] = rsqrtf(((pnext[0] + pnext[1]) + (pnext[2] + pnext[3])) * (1.0f / 1024.0f) + eps);
    }
    __device__ __forceinline__ void fused(const f32x4 (&acc)[2][2][4][2], const Unit& u, int wr, int wc, int fr, int fq, PG8_LAS unsigned char* lds, int wid, int lane) const {
        asm volatile("" : "+v"(fr), "+v"(fq), "+v"(lane));
        const bool last = (mode == 4) && (l + 1 == DEPTH);
        bf16_t* xb = (bf16_t*)(ws + WS_XB); float* outf = last ? outp : nullptr;
        const float* gains = (const float*)(ws + WS_GAIN);
        const float* gpost = gains + (l * 4 + (mode == 3 ? 1 : 3)) * D_MODEL;
        float* ps1 = (float*)(ws + WS_PS1); float* ps2 = (float*)(ws + WS_PS2); unsigned* cnt = (unsigned*)(ws + WS_CNT) + (size_t)(2 * l + (mode == 4 ? 1 : 0)) * 256 * 16; const float eps = NORM_EPS;
        PG8_LAS float* P1 = (PG8_LAS float*)(lds + 131072);
        PG8_LAS float* S1 = (PG8_LAS float*)(lds + 131072 + 4096);
        PG8_LAS float* P2 = (PG8_LAS float*)(lds + 131072 + 5120);
        const int tid = wid * 64 + lane;
#pragma unroll
        for (int ai = 0; ai < 2; ++ai)
#pragma unroll
            for (int m = 0; m < 4; ++m) { float s = 0.f;
#pragma unroll
                for (int bj = 0; bj < 2; ++bj)
#pragma unroll
                    for (int n = 0; n < 2; ++n) { const f32x4 x = acc[ai][bj][m][n]; s += (x[0] * x[0] + x[1] * x[1]) + (x[2] * x[2] + x[3] * x[3]); }
                s += shx(s, 16); s += shx(s, 32);
                if (fq == 0) P1[(ai * HALF + wr * 64 + m * 16 + fr) * 4 + wc] = s; }
        asm volatile("s_waitcnt lgkmcnt(0)" ::: "memory"); __builtin_amdgcn_s_barrier(); asm volatile("" ::: "memory");
        if (tid < 256) { const f32x4 p = *(const PG8_LAS f32x4*)(P1 + tid * 4);
            __hip_atomic_store(ps1 + ((size_t)(u.pm * BM + tid)) * 4 + u.pn, (p[0] + p[1]) + (p[2] + p[3]), PG8_RLX_AGENT);
            asm volatile("s_waitcnt vmcnt(0)" ::: "memory");
            if (lane == 0) __hip_atomic_fetch_add(cnt + 16 * u.pm, 1u, PG8_RLX_AGENT); }
        if (wid == 0) { unsigned spins = 0;
            while ((unsigned)__builtin_amdgcn_readfirstlane((int)__hip_atomic_load(cnt + 16 * u.pm, PG8_RLX_AGENT)) < 16u) { __builtin_amdgcn_s_sleep(2); if (++spins > (1u << 21)) break; }
            __builtin_amdgcn_fence(__ATOMIC_ACQUIRE, "agent"); asm volatile("s_waitcnt vmcnt(0)" ::: "memory"); }
        asm volatile("s_waitcnt lgkmcnt(0)" ::: "memory"); __builtin_amdgcn_s_barrier(); asm volatile("" ::: "memory");
        if (tid < 256) { const float* q = ps1 + ((size_t)(u.pm * BM + tid)) * 4;
            const float t = (__hip_atomic_load(q, PG8_RLX_AGENT) + __hip_atomic_load(q + 1, PG8_RLX_AGENT)) + (__hip_atomic_load(q + 2, PG8_RLX_AGENT) + __hip_atomic_load(q + 3, PG8_RLX_AGENT));
            S1[tid] = rsqrtf(t * (1.0f / 1024.0f) + eps); }
        asm volatile("s_waitcnt lgkmcnt(0)" ::: "memory"); __builtin_amdgcn_s_barrier(); asm volatile("" ::: "memory");
        const int col0 = u.pn * BM + wc * 32 + 8 * fq;
        f32x4 g1[2][2];
#pragma unroll
        for (int bj = 0; bj < 2; ++bj)
#pragma unroll
            for (int n = 0; n < 2; ++n) { g1[bj][n] = *(const f32x4*)(gpost + col0 + bj * HALF + 4 * n); }
#pragma unroll
        for (int ai = 0; ai < 2; ++ai) {
            u32x4 xq[4][2];
#pragma unroll
            for (int m = 0; m < 4; ++m) { const size_t off = (size_t)(u.pm * BM + ai * HALF + wr * 64 + m * 16 + fr) * 1024 + col0;
#pragma unroll
                for (int bj = 0; bj < 2; ++bj) {
                    xq[m][bj] = *(const u32x4*)(xb + off + bj * HALF); } }
#pragma unroll
            for (int m = 0; m < 4; ++m) { const int rl = ai * HALF + wr * 64 + m * 16 + fr; const size_t off = (size_t)(u.pm * BM + rl) * 1024 + col0; const float rstd = S1[rl]; float s2 = 0.f;
#pragma unroll
                for (int bj = 0; bj < 2; ++bj) { f32x4 x0, x1;
                    { const u32x4 w = xq[m][bj];
                        x0 = (f32x4){__uint_as_float(w.x << 16), __uint_as_float(w.x & 0xffff0000u), __uint_as_float(w.y << 16), __uint_as_float(w.y & 0xffff0000u)};
                        x1 = (f32x4){__uint_as_float(w.z << 16), __uint_as_float(w.z & 0xffff0000u), __uint_as_float(w.w << 16), __uint_as_float(w.w & 0xffff0000u)}; }
                    f32x4 v0 = x0 + acc[ai][bj][m][0] * rstd * g1[bj][0], v1 = x1 + acc[ai][bj][m][1] * rstd * g1[bj][1];
                    if (outf) { float* op = outf + off + bj * HALF; *(f32x4*)op = v0; *(f32x4*)(op + 4) = v1; }
                    else { u32x4 w; w.x = pk2(v0[0], v0[1]); w.y = pk2(v0[2], v0[3]); w.z = pk2(v1[0], v1[1]); w.w = pk2(v1[2], v1[3]);
                        *(u32x4*)(xb + off + bj * HALF) = w;
                        v0 = (f32x4){__uint_as_float(w.x << 16), __uint_as_float(w.x & 0xffff0000u), __uint_as_float(w.y << 16), __uint_as_float(w.y & 0xffff0000u)};
                        v1 = (f32x4){__uint_as_float(w.z << 16), __uint_as_float(w.z & 0xffff0000u), __uint_as_float(w.w << 16), __uint_as_float(w.w & 0xffff0000u)};
                        s2 += ((v0[0] * v0[0] + v0[1] * v0[1]) + (v0[2] * v0[2] + v0[3] * v0[3])) + ((v1[0] * v1[0] + v1[1] * v1[1]) + (v1[2] * v1[2] + v1[3] * v1[3]));
                    } }
                if (!outf) { s2 += shx(s2, 16); s2 += shx(s2, 32); if (fq == 0) P2[rl * 4 + wc] = s2; } }
            asm volatile("" ::: "memory");
        }
        if (!outf) {
            asm volatile("s_waitcnt lgkmcnt(0)" ::: "memory"); __builtin_amdgcn_s_barrier(); asm volatile("" ::: "memory");
            if (tid < 256) { const f32x4 p = *(const PG8_LAS f32x4*)(P2 + tid * 4); ps2[((size_t)(u.pm * BM + tid)) * 4 + u.pn] = (p[0] + p[1]) + (p[2] + p[3]); } }
    }
};
template <class Epi, class Sched, bool ALIGN_EPI = false, bool SP2 = false>
__device__ __forceinline__ void gemm_phase(PG8_LAS unsigned char* lds, const Gemm g, const Sched& S, const Epi& E, const int tid) {
    const int wid = __builtin_amdgcn_readfirstlane(tid >> 6), lane = tid & 63, wr = wid >> 2, wc = wid & 3, fr = lane & 15, fq = lane >> 4;
    const int K = g.K, nt = K / BK;
    unsigned voffA[2], voffB[2];
#pragma unroll
    for (int i = 0; i < 2; ++i) { int R, C; stage_rc(tid * 16 + i * 8192, R, C); const int Rb = Epi::PERM ? ((R & ~31) + perm32(R & 31)) : R;
        voffA[i] = (unsigned)(R * K + C) * 2u; voffB[i] = (unsigned)(Rb * K + C) * 2u; }
    const size_t kstep = (size_t)(BK * 2);
    const size_t hstep = (size_t)HALF * K * 2;
    const size_t tstep = 2 * hstep;
    const unsigned ldsw = (unsigned)wid * 1024u;
    const int aoff = lds_byte(wr * 64 + fr, fq * 8), boff = lds_byte(wc * 32 + fr, fq * 8);
#define PG8_SA(b, h) (((b) * 2 + (h)) * HTB)
#define PG8_SB(b, h) ((4 + (b) * 2 + (h)) * HTB)
#define PG8_STAGE(bufoff, gbase, voff) do { _Pragma("unroll") for (int _i = 0; _i < 2; ++_i) \
        __builtin_amdgcn_global_load_lds((const unsigned*)((const char*)(gbase) + (voff)[_i]), (PG8_LAS unsigned*)(lds + (bufoff) + ldsw + _i * 8192), 16, 0, 0); } while (0)
#define PG8_LDA(dst, b, h) do { _Pragma("unroll") for (int m = 0; m < 4; ++m) _Pragma("unroll") for (int k = 0; k < 2; ++k) dst[m][k] = *(const PG8_LAS bf16x8*)(lds + PG8_SA(b, h) + aoff + m * 2048 + k * 1024); } while (0)
#define PG8_LDB(dst, b, h) do { _Pragma("unroll") for (int n = 0; n < 2; ++n) _Pragma("unroll") for (int k = 0; k < 2; ++k) dst[n][k] = *(const PG8_LAS bf16x8*)(lds + PG8_SB(b, h) + boff + n * 2048 + k * 1024); } while (0)
#define PG8_MMA(ai, bj, At, Bt) do { __builtin_amdgcn_s_setprio(1); _Pragma("unroll") for (int m = 0; m < 4; ++m) _Pragma("unroll") for (int n = 0; n < 2; ++n) _Pragma("unroll") for (int k = 0; k < 2; ++k) \
        acc[ai][bj][m][n] = __builtin_amdgcn_mfma_f32_16x16x32_bf16(Bt[n][k], At[m][k], acc[ai][bj][m][n], 0, 0, 0); __builtin_amdgcn_s_setprio(0); } while (0)
#define PG8_WAIT_V(n) asm volatile("s_waitcnt vmcnt(" #n ")" ::: "memory")
#define PG8_WAIT_L(n) asm volatile("s_waitcnt lgkmcnt(" #n ")" ::: "memory")
#define PG8_BAR __builtin_amdgcn_s_barrier()
#define PG8_SCHED __builtin_amdgcn_sched_barrier(0)
    Unit cur, nxt; int ui = 0;
    if (!S.next(0, cur)) return;
    f32x4 acc[2][2][4][2];
#pragma unroll
    for (int a = 0; a < 2; ++a)
#pragma unroll
        for (int b = 0; b < 2; ++b)
#pragma unroll
            for (int m = 0; m < 4; ++m)
#pragma unroll
                for (int n = 0; n < 2; ++n) acc[a][b][m][n] = (f32x4){0.f, 0.f, 0.f, 0.f};
    bf16x8 At[4][2], B0[2][2], B1[2][2];
    const char* cA = (const char*)g.A + (size_t)cur.pm * tstep; const char* cB = (const char*)g.Bt + (size_t)cur.pn * tstep;
    S.a_ready(cur);
    E.prime(cur.pm, lds, wid * 64 + lane);
    if constexpr (SP2) {
        PG8_STAGE(PG8_SB(0, 0), cB, voffB); PG8_STAGE(PG8_SB(0, 1), cB + hstep, voffB); PG8_STAGE(PG8_SA(0, 0), cA, voffA); PG8_STAGE(PG8_SA(0, 1), cA + hstep, voffA);
        if (wr == 1) PG8_BAR;
        PG8_WAIT_V(2); PG8_BAR;
        PG8_STAGE(PG8_SB(1, 0), cB + kstep, voffB); PG8_STAGE(PG8_SA(1, 0), cA + kstep, voffA); PG8_STAGE(PG8_SB(1, 1), cB + hstep + kstep, voffB);
        PG8_WAIT_V(6); PG8_BAR;
    } else {
        PG8_STAGE(PG8_SB(0, 0), cB, voffB); PG8_STAGE(PG8_SA(0, 0), cA, voffA); PG8_STAGE(PG8_SB(0, 1), cB + hstep, voffB); PG8_STAGE(PG8_SA(0, 1), cA + hstep, voffA);
        if (wr == 1) PG8_BAR;
        PG8_WAIT_V(4); PG8_BAR;
        PG8_STAGE(PG8_SB(1, 0), cB + kstep, voffB); PG8_STAGE(PG8_SA(1, 0), cA + kstep, voffA); PG8_STAGE(PG8_SB(1, 1), cB + hstep + kstep, voffB);
        PG8_WAIT_V(6); PG8_BAR;
    }
    for (;;) {
        const bool has_next = S.next(ui + 1, nxt);
        const char* nA = has_next ? (const char*)g.A + (size_t)nxt.pm * tstep : cA; const char* nB = has_next ? (const char*)g.Bt + (size_t)nxt.pn * tstep : cB;
        for (int t = 0; t < nt; t += 2) {
            const bool last = (t == nt - 2);
            const char* a1 = cA + (size_t)(t + 1) * kstep;
            const char* a2 = last ? nA : cA + (size_t)(t + 2) * kstep; const char* b2 = last ? nB : cB + (size_t)(t + 2) * kstep;
            const char* a3 = a2 + kstep; const char* b3 = b2 + kstep;
            if (last && has_next) S.a_ready(nxt);
            if constexpr (SP2) {
            PG8_LDB(B0, 0, 0); PG8_LDB(B1, 0, 1); PG8_SCHED; PG8_LDA(At, 0, 0); PG8_STAGE(PG8_SA(1, 1), a1 + hstep, voffA);
            PG8_WAIT_V(8); PG8_WAIT_L(0); PG8_BAR; PG8_MMA(0, 0, At, B0); PG8_MMA(0, 1, At, B1); PG8_BAR; PG8_SCHED;
            PG8_LDA(At, 0, 1); PG8_STAGE(PG8_SB(0, 0), b2, voffB); PG8_STAGE(PG8_SB(0, 1), b2 + hstep, voffB); PG8_STAGE(PG8_SA(0, 0), a2, voffA);
            PG8_WAIT_V(8); PG8_WAIT_L(0); PG8_BAR; PG8_MMA(1, 0, At, B0); PG8_MMA(1, 1, At, B1); PG8_BAR; PG8_SCHED;
            PG8_LDB(B0, 1, 0); PG8_LDB(B1, 1, 1); PG8_SCHED; PG8_LDA(At, 1, 0); PG8_STAGE(PG8_SA(0, 1), a2 + hstep, voffA);
            PG8_WAIT_V(8); PG8_WAIT_L(0); PG8_BAR; PG8_MMA(0, 0, At, B0); PG8_MMA(0, 1, At, B1); PG8_BAR; PG8_SCHED;
            PG8_LDA(At, 1, 1); PG8_STAGE(PG8_SB(1, 0), b3, voffB); PG8_STAGE(PG8_SB(1, 1), b3 + hstep, voffB); PG8_STAGE(PG8_SA(1, 0), a3, voffA);
            PG8_WAIT_V(8); PG8_WAIT_L(0); PG8_BAR; PG8_MMA(1, 0, At, B0); PG8_MMA(1, 1, At, B1); PG8_BAR; PG8_SCHED;
            } else {
            PG8_LDB(B0, 0, 0); PG8_SCHED; PG8_LDA(At, 0, 0); PG8_STAGE(PG8_SA(1, 1), a1 + hstep, voffA);
            PG8_WAIT_L(8); PG8_BAR; PG8_WAIT_L(0); PG8_MMA(0, 0, At, B0); PG8_BAR; PG8_SCHED;
            PG8_LDB(B1, 0, 1); PG8_STAGE(PG8_SB(0, 0), b2, voffB);
            PG8_BAR; PG8_WAIT_L(0); PG8_MMA(0, 1, At, B1); PG8_BAR;
            PG8_LDA(At, 0, 1); PG8_STAGE(PG8_SA(0, 0), a2, voffA);
            PG8_BAR; PG8_WAIT_L(0); PG8_MMA(1, 0, At, B0); PG8_BAR; PG8_SCHED;
            PG8_STAGE(PG8_SB(0, 1), b2 + hstep, voffB);
            PG8_WAIT_V(6); PG8_BAR; PG8_MMA(1, 1, At, B1); PG8_BAR;
            PG8_LDB(B0, 1, 0); PG8_SCHED; PG8_LDA(At, 1, 0); PG8_STAGE(PG8_SA(0, 1), a2 + hstep, voffA);
            PG8_WAIT_L(8); PG8_BAR; PG8_WAIT_L(0); PG8_MMA(0, 0, At, B0); PG8_BAR; PG8_SCHED;
            PG8_LDB(B1, 1, 1); PG8_STAGE(PG8_SB(1, 0), b3, voffB);
            PG8_BAR; PG8_WAIT_L(0); PG8_MMA(0, 1, At, B1); PG8_BAR;
            PG8_LDA(At, 1, 1); PG8_STAGE(PG8_SA(1, 0), a3, voffA);
            PG8_BAR; PG8_WAIT_L(0); PG8_MMA(1, 0, At, B0); PG8_BAR; PG8_SCHED;
            PG8_STAGE(PG8_SB(1, 1), b3 + hstep, voffB);
            PG8_WAIT_V(6); PG8_BAR; PG8_MMA(1, 1, At, B1); PG8_BAR;
            }
        }
        if constexpr (ALIGN_EPI) { if (wr == 0) PG8_BAR; }
        if constexpr (!Epi::AFTER_DRAIN) { E(acc, cur, wr, wc, fr, fq, lds, wid, lane, has_next ? nxt.pm : -1, ui & 1); S.done(cur); }
        if (!has_next) break;
#pragma unroll
        for (int a = 0; a < 2; ++a)
#pragma unroll
            for (int b = 0; b < 2; ++b)
#pragma unroll
                for (int m = 0; m < 4; ++m)
#pragma unroll
                    for (int n = 0; n < 2; ++n) acc[a][b][m][n] = (f32x4){0.f, 0.f, 0.f, 0.f};
        cur = nxt; cA = nA; cB = nB; ++ui;
        if constexpr (ALIGN_EPI) { if (wr == 1) PG8_BAR; }
    }
    PG8_WAIT_V(0);
    if constexpr (!ALIGN_EPI) { if (wr == 0) PG8_BAR; }
    PG8_BAR;
    if constexpr (Epi::AFTER_DRAIN) { E.fused(acc, cur, wr, wc, fr, fq, lds, wid, lane); S.done(cur); }
#undef PG8_SA
#undef PG8_SB
#undef PG8_STAGE
#undef PG8_LDA
#undef PG8_LDB
#undef PG8_MMA
#undef PG8_WAIT_V
#undef PG8_WAIT_L
#undef PG8_BAR
#undef PG8_SCHED
}
}
#define LAS __attribute__((address_space(3)))
typedef LAS unsigned char* ldsp;
typedef unsigned short bf16_t;
typedef short bf16x8 __attribute__((ext_vector_type(8)));
typedef short s16x4 __attribute__((ext_vector_type(4)));
typedef float f32x4 __attribute__((ext_vector_type(4)));
typedef float f32x16 __attribute__((ext_vector_type(16)));
typedef unsigned u32x4 __attribute__((ext_vector_type(4)));
typedef unsigned u32x2 __attribute__((ext_vector_type(2)));
using pg8::pk2;
#define DI __device__ __forceinline__
#define LDS_WAIT() asm volatile("s_waitcnt lgkmcnt(0)" ::: "memory")

DI f32x16 mfma32(bf16x8 a, bf16x8 b, f32x16 c) { return __builtin_amdgcn_mfma_f32_32x32x16_bf16(a, b, c, 0, 0, 0); }
DI constexpr int crow(int i, int h) { return (i & 3) + 8 * (i >> 2) + 4 * h; }
DI float bf2f(unsigned short b) { return __uint_as_float(((unsigned)b) << 16); }
DI f32x16 zero16() { f32x16 z;
#pragma unroll
  for (int i = 0; i < 16; ++i) z[i] = 0.f; return z; }
DI bf16x8 pack8(const f32x16& x, const int s) { u32x4 p; p.x = pk2(x[8 * s], x[8 * s + 1]); p.y = pk2(x[8 * s + 2], x[8 * s + 3]); p.z = pk2(x[8 * s + 4], x[8 * s + 5]); p.w = pk2(x[8 * s + 6], x[8 * s + 7]); return __builtin_bit_cast(bf16x8, p); }
DI float lg2gamma(int head) { return log2f(1.0f - exp2f(-5.0f - (float)head)); }
DI int launder(int x) { asm volatile("" : "+v"(x)); return x; }
template <int CTRL> DI float dpp_add(float v) { return v + __int_as_float(__builtin_amdgcn_update_dpp(0, __float_as_int(v), CTRL, 0xF, 0xF, true)); }
DI float wave_sum(float v) {
    v = dpp_add<0xB1>(v);
    v = dpp_add<0x4E>(v);
    v = dpp_add<0x141>(v);
    v = dpp_add<0x140>(v);
    v += __int_as_float(__builtin_amdgcn_ds_swizzle(__float_as_int(v), 0x401F));
    v += shx(v, 32);
    return v; }

#define XB_TMO      128
#define XB_XCNT(j)  (256  + 64 * (j))
#define XB_XSUB(j)  (1280 + 64 * (j))
#define XB_XGEN(j)  (2304 + 64 * (j))
#define XB_TOP      3328
#define XB_TOPGEN   3392
#define XCD_BAR_WORDS 3456
#define XB_SPIN_CAP (1u << 18)

__device__ __forceinline__ unsigned xb_ld(unsigned* p)              { return __hip_atomic_load(p, __ATOMIC_RELAXED, __HIP_MEMORY_SCOPE_AGENT); }
__device__ __forceinline__ unsigned xb_add(unsigned* p, unsigned v) { return __hip_atomic_fetch_add(p, v, __ATOMIC_RELAXED, __HIP_MEMORY_SCOPE_AGENT); }
__device__ __forceinline__ unsigned xb_xcc_id() { return (unsigned)__builtin_amdgcn_s_getreg((3 << 11) | 20) & 0xFu; }
#define XB_SPIN(cond, bar) do { unsigned _sp = 0; while (cond) { __builtin_amdgcn_s_sleep(1); \
    if ((++_sp & 255u) == 0u) { if (xb_ld(&(bar)[XB_TMO])) break; if (_sp > XB_SPIN_CAP) { atomicAdd(&(bar)[XB_TMO], 1u); break; } } } } while (0)

struct XcdBarrier {
    unsigned* bar; unsigned x;
    volatile LAS unsigned* st;
};

__device__ __forceinline__ XcdBarrier xcd_barrier_post(unsigned* bar, volatile LAS unsigned* st) {
    XcdBarrier b; b.bar = bar; b.x = xb_xcc_id(); b.st = st;
    if (threadIdx.x == 0) (void)xb_add(&bar[XB_XCNT(b.x)], 1u);
    return b;
}
__device__ __forceinline__ void xcd_barrier_complete(unsigned* bar, unsigned x, unsigned& nloc, unsigned& nx) {
    const unsigned G = gridDim.x * gridDim.y * gridDim.z;
    unsigned sum, cnt, mine, sp = 0u;
    for (;;) {
        sum = 0u; cnt = 0u; mine = 0u;
#pragma unroll
        for (unsigned j = 0; j < 16; ++j) { const unsigned c = xb_ld(&bar[XB_XCNT(j)]); sum += c; cnt += (c > 0u) ? 1u : 0u; mine = (j == x) ? c : mine; }
        if (sum == G) break;
        __builtin_amdgcn_s_sleep(1);
        if ((++sp & 255u) == 0u) { if (xb_ld(&bar[XB_TMO])) break; if (sp > XB_SPIN_CAP) { atomicAdd(&bar[XB_TMO], 1u); break; } }
    }
    nloc = mine > 0u ? mine : 1u; nx = cnt > 0u ? cnt : 1u;
}

__device__ __forceinline__ void xcd_barrier(const XcdBarrier& b) {
    asm volatile("s_waitcnt vmcnt(0)" ::: "memory");
    __syncthreads();
    if (threadIdx.x == 0) {
        unsigned* bar = b.bar;
        __builtin_amdgcn_s_waitcnt(0);
        unsigned nloc = b.st[0], nx = b.st[1];
        if (nloc == 0u) { xcd_barrier_complete(bar, b.x, nloc, nx); b.st[0] = nloc; b.st[1] = nx; }
        const unsigned old = xb_add(&bar[XB_XSUB(b.x)], 1u);
        const unsigned gen = old / nloc;
        if (old + 1u == (gen + 1u) * nloc) {
            __builtin_amdgcn_fence(__ATOMIC_RELEASE, "agent");
            asm volatile("s_waitcnt vmcnt(0)" ::: "memory");
            const unsigned og = xb_add(&bar[XB_TOP], 1u);
            const unsigned tg = og / nx;
            if (og + 1u == (tg + 1u) * nx) xb_add(&bar[XB_TOPGEN], 1u);
            else XB_SPIN(xb_ld(&bar[XB_TOPGEN]) == tg, bar);
            __builtin_amdgcn_fence(__ATOMIC_ACQUIRE, "agent");
            xb_add(&bar[XB_XGEN(b.x)], 1u);
            asm volatile("s_waitcnt vmcnt(0)" ::: "memory");
        } else {
            XB_SPIN(xb_ld(&bar[XB_XGEN(b.x)]) == gen, bar);
            __builtin_amdgcn_fence(__ATOMIC_ACQUIRE, "agent");
            asm volatile("s_waitcnt vmcnt(0)" ::: "memory");
        }
    }
    __syncthreads();
}

DI void stage_rows(ldsp dst, const bf16_t* src, size_t pitch, int nrows, int tid) {
    for (int it = tid; it < nrows * 8; it += NTHREADS) { const int r = it >> 3, c = it & 7;
        const u32x4 v = *(const u32x4*)(src + (size_t)r * pitch + c * 8);
        *(LAS u32x4*)(dst + r * 144 + c * 16) = v; }
}
template <int NT> DI void stage_tiles(ldsp lds, const int (&dstoff)[NT], const bf16_t* const (&src)[NT], const float (&lg)[NT], int tid) {
    u32x4 v[NT][2];
    const int r0 = tid >> 3, c = tid & 7;
#pragma unroll
    for (int t = 0; t < NT; ++t)
#pragma unroll
        for (int i = 0; i < 2; ++i) v[t][i] = *(const u32x4*)(src[t] + (size_t)(r0 + 64 * i) * PW + c * 8);
#pragma unroll
    for (int t = 0; t < NT; ++t)
#pragma unroll
        for (int i = 0; i < 2; ++i) { u32x4 o = v[t][i];
            if (lg[t] != 0.f) { const float sc = exp2f((float)(127 - (r0 + 64 * i)) * lg[t]);
                o.x = pk2(__uint_as_float(o.x << 16) * sc, __uint_as_float(o.x & 0xffff0000u) * sc); o.y = pk2(__uint_as_float(o.y << 16) * sc, __uint_as_float(o.y & 0xffff0000u) * sc);
                o.z = pk2(__uint_as_float(o.z << 16) * sc, __uint_as_float(o.z & 0xffff0000u) * sc); o.w = pk2(__uint_as_float(o.w << 16) * sc, __uint_as_float(o.w & 0xffff0000u) * sc); }
            *(LAS u32x4*)(lds + dstoff[t] + (r0 + 64 * i) * 144 + c * 16) = o; }
}
DI void stage_rows_scaled(ldsp dst, const bf16_t* src, size_t pitch, int nrows, int tid, float lg) {
    for (int it = tid; it < nrows * 8; it += NTHREADS) { const int r = it >> 3, c = it & 7;
        const u32x4 v = *(const u32x4*)(src + (size_t)r * pitch + c * 8); const float sc = exp2f((float)(127 - r) * lg);
        u32x4 o; o.x = pk2(__uint_as_float(v.x << 16) * sc, __uint_as_float(v.x & 0xffff0000u) * sc); o.y = pk2(__uint_as_float(v.y << 16) * sc, __uint_as_float(v.y & 0xffff0000u) * sc);
        o.z = pk2(__uint_as_float(v.z << 16) * sc, __uint_as_float(v.z & 0xffff0000u) * sc); o.w = pk2(__uint_as_float(v.w << 16) * sc, __uint_as_float(v.w & 0xffff0000u) * sc);
        *(LAS u32x4*)(dst + r * 144 + c * 16) = o; }
}
template <bool SCALE> DI void stage_T(ldsp dst, int stride, int key0, const bf16_t* src, size_t pitch, int nrows, int tid, float lg) {
    for (int it = tid; it < nrows * 8; it += NTHREADS) { const int r = it >> 3, c = it & 7;
        const u32x4 v = *(const u32x4*)(src + (size_t)r * pitch + c * 8);
        unsigned w[4] = {v.x, v.y, v.z, v.w};
        float sc = 1.f; if (SCALE) sc = exp2f((float)(127 - r) * lg);
#pragma unroll
        for (int j = 0; j < 8; ++j) { unsigned short e = (unsigned short)((j & 1) ? (w[j >> 1] >> 16) : (w[j >> 1] & 0xffffu));
            if (SCALE) { e = (unsigned short)(pk2(bf2f(e) * sc, 0.f) & 0xffffu); }
            *(LAS unsigned short*)(dst + ((8 * c + j) * stride + key0 + r) * 2) = e; } }
}
DI bf16x8 kfrag(ldsp Kb, int row, int kk, int h) { return *(const LAS bf16x8*)(Kb + row * 144 + (16 * kk + 8 * h) * 2); }
DI bf16x8 vtfrag_perm(ldsp Vb, int stride, int row, int key0, int h) {
    const s16x4 lo = *(const LAS s16x4*)(Vb + (row * stride + key0 + 4 * h) * 2), hi = *(const LAS s16x4*)(Vb + (row * stride + key0 + 8 + 4 * h) * 2);
    return __builtin_shufflevector(lo, hi, 0, 1, 2, 3, 4, 5, 6, 7); }
DI int vt_lane_off(int lane) { const int i = lane & 15; return (i >> 2) * 144 + (16 * ((lane >> 4) & 1) + 4 * (i & 3)) * 2; }
DI s16x4 tr_read(ldsp p) { return __builtin_amdgcn_ds_read_tr16_b64_v4i16((LAS s16x4*)p); }
DI bf16x8 vfrag_perm_tr(ldsp Vb, int loff, int col0, int key0, int h) {
    ldsp p = Vb + (key0 + 4 * h) * 144 + col0 * 2 + loff;
    const s16x4 lo = tr_read(p), hi = tr_read(p + 8 * 144);
    return __builtin_shufflevector(lo, hi, 0, 1, 2, 3, 4, 5, 6, 7); }
DI bf16x8 vfrag_nat_tr(ldsp Vb, int loff, int col0, int key0, int h) {
    ldsp p = Vb + (key0 + 8 * h) * 144 + col0 * 2 + loff;
    const s16x4 lo = tr_read(p), hi = tr_read(p + 4 * 144);
    return __builtin_shufflevector(lo, hi, 0, 1, 2, 3, 4, 5, 6, 7); }
DI bf16x8 vtfrag_nat(ldsp Vb, int stride, int row, int key0, int h) {
    const s16x4 lo = *(const LAS s16x4*)(Vb + (row * stride + key0 + 8 * h) * 2), hi = *(const LAS s16x4*)(Vb + (row * stride + key0 + 8 * h + 4) * 2);
    return __builtin_shufflevector(lo, hi, 0, 1, 2, 3, 4, 5, 6, 7); }

DI void swa_unit(ldsp lds, int u, const bf16_t* PROJ, bf16_t* MIXED, const float* sinks, const float* ga, int tid) {
    tid = launder(tid);
    const int b = u >> 6, nb = u & 63;
    const size_t tok0 = (size_t)b * SEQ + (size_t)nb * 128, prev0 = nb > 0 ? tok0 - 128 : tok0;
    ldsp Ks = lds, VTs = lds + 73728; LAS float* xs = (LAS float*)(lds + 147456);
    __syncthreads();
    {   const int dsto[8] = {0, 128 * 144, 36864, 36864 + 128 * 144, 73728, 73728 + 128 * 144, 73728 + 36864, 73728 + 36864 + 128 * 144};
        const bf16_t* const srcs[8] = {PROJ + prev0 * PW + C_KA, PROJ + tok0 * PW + C_KA, PROJ + prev0 * PW + C_KA + 64, PROJ + tok0 * PW + C_KA + 64,
                                       PROJ + prev0 * PW + C_VA, PROJ + tok0 * PW + C_VA, PROJ + prev0 * PW + C_VA + 64, PROJ + tok0 * PW + C_VA + 64};
        const float lgs[8] = {0.f, 0.f, 0.f, 0.f, 0.f, 0.f, 0.f, 0.f};
        stage_tiles<8>(lds, dsto, srcs, lgs, tid); }
    __syncthreads();
    const int wave = __builtin_amdgcn_readfirstlane(tid >> 6), lane = tid & 63, rt = wave & 3, hk = wave >> 2, qi = lane & 31, h = lane >> 5;
    const int qrow = 32 * rt + qi; const size_t token = tok0 + qrow;
    ldsp Kh = Ks + hk * 36864, Vh = VTs + hk * 36864; const int loff = vt_lane_off(lane);
    u32x2 Op[3][2][4]; float ssq = 0.f;
#pragma unroll
    for (int hh = 0; hh < 3; ++hh) {
        const int head = 3 * hk + hh; f32x16 O[2];
        bf16x8 q[4];
#pragma unroll
        for (int kk = 0; kk < 4; ++kk) q[kk] = *(const bf16x8*)(PROJ + token * PW + C_QA + head * 64 + 16 * kk + 8 * h);
        const float sink = sinks[head]; float mx = sink, den = 1.0f;
        O[0] = zero16(); O[1] = zero16();
#pragma unroll
        for (int ti = 0; ti < 5; ++ti) {
            f32x16 s = zero16();
#pragma unroll
            for (int kk = 0; kk < 4; ++kk) s = mfma32(kfrag(Kh, 32 * (rt + ti) + qi, kk, h), q[kk], s);
            float tm = -INFINITY;
            const int kb0 = 32 * (rt + ti) + 4 * h, lo_t = launder(max(qrow, nb > 0 ? -1 : 127) - kb0), hi_t = launder(128 + qrow - kb0);
#pragma unroll
            for (int i = 0; i < 16; ++i) { const int c = (i & 3) + 8 * (i >> 2);
                const bool valid = (c > lo_t) && (c <= hi_t);
                const float v = valid ? s[i] : -INFINITY; s[i] = v; tm = fmaxf(tm, v); }
            tm = fmaxf(tm, shx(tm, 32));
            const float mn = fmaxf(mx, tm), sc = __expf(mx - mn); mx = mn;
            float ps = 0.f;
#pragma unroll
            for (int i = 0; i < 16; ++i) { const float p = __expf(s[i] - mn); s[i] = p; ps += p; }
            den = den * sc + ps;
#pragma unroll
            for (int dd = 0; dd < 2; ++dd)
#pragma unroll
                for (int i = 0; i < 16; ++i) O[dd][i] *= sc;
#pragma unroll
            for (int s2 = 0; s2 < 2; ++s2) { const bf16x8 P = pack8(s, s2);
#pragma unroll
                for (int dd = 0; dd < 2; ++dd) O[dd] = mfma32(vfrag_perm_tr(Vh, loff, 32 * dd, 32 * (rt + ti) + 16 * s2, h), P, O[dd]); }
            asm volatile("" ::: "memory");
        }
        den += shx(den, 32) - __expf(sink - mx);
        const float inv = 1.0f / den;
#pragma unroll
        for (int dd = 0; dd < 2; ++dd)
#pragma unroll
            for (int i = 0; i < 16; ++i) { const float o = O[dd][i] * inv; O[dd][i] = o; ssq += o * o; }
#pragma unroll
        for (int dd = 0; dd < 2; ++dd)
#pragma unroll
            for (int g = 0; g < 4; ++g) { Op[hh][dd][g].x = pk2(O[dd][4 * g], O[dd][4 * g + 1]); Op[hh][dd][g].y = pk2(O[dd][4 * g + 2], O[dd][4 * g + 3]); }
    }
    ssq += shx(ssq, 32);
    if (h == 0) xs[hk * 128 + qrow] = ssq;
    __syncthreads();
    const float rstd = rsqrtf((xs[qrow] + xs[128 + qrow]) * (1.0f / 384.0f) + NORM_EPS);
#pragma unroll
    for (int hh = 0; hh < 3; ++hh)
#pragma unroll
        for (int dd = 0; dd < 2; ++dd)
#pragma unroll
            for (int g = 0; g < 4; ++g) { const int col = (3 * hk + hh) * 64 + 32 * dd + 8 * g + 4 * h; const f32x4 gg = *(const f32x4*)(ga + col);
                const u32x2 pk = Op[hh][dd][g]; const float o0 = __uint_as_float(pk.x << 16), o1 = __uint_as_float(pk.x & 0xffff0000u), o2 = __uint_as_float(pk.y << 16), o3 = __uint_as_float(pk.y & 0xffff0000u);
                u32x2 w; w.x = pk2(o0 * rstd * gg[0], o1 * rstd * gg[1]); w.y = pk2(o2 * rstd * gg[2], o3 * rstd * gg[3]);
                *(u32x2*)(MIXED + token * D_MODEL + col) = w; }
}

DI float sb_tile(ldsp Kh, ldsp Vh, int loff, const bf16x8 (&q)[4], f32x16 (&O)[2], float R, int kt, bool diag, int qi, int h) {
    f32x16 z = zero16();
#pragma unroll
    for (int kk = 0; kk < 4; ++kk) z = mfma32(kfrag(Kh, 32 * kt + qi, kk, h), q[kk], z);
    const int lim = launder(diag ? (qi - 4 * h) : 64);
    float lb[16], v[16];
#pragma unroll
    for (int i = 0; i < 16; ++i) { const float zz = z[i], e = __expf(-fabsf(zz)), l = fminf(zz, 0.f) - __logf(1.0f + e);
        const bool strict = ((i & 3) + 8 * (i >> 2)) < lim; lb[i] = l; v[i] = strict ? (l - zz) : 0.f; }
    float t[16], G[4], P[4], off[4];
#pragma unroll
    for (int g = 0; g < 4; ++g) { t[4 * g + 3] = 0.f; t[4 * g + 2] = v[4 * g + 3]; t[4 * g + 1] = t[4 * g + 2] + v[4 * g + 2]; t[4 * g] = t[4 * g + 1] + v[4 * g + 1]; G[g] = t[4 * g] + v[4 * g]; }
#pragma unroll
    for (int g = 0; g < 4; ++g) P[g] = shx(G[g], 32);
    float run = 0.f;
#pragma unroll
    for (int g = 3; g >= 0; --g) { off[g] = h ? run : (run + P[g]); run += (G[g] + P[g]); }
#pragma unroll
    for (int i = 0; i < 16; ++i) { const bool strict = ((i & 3) + 8 * (i >> 2)) < lim;
        const float w = strict ? __expf(lb[i] + t[i] + off[i >> 2] + R) : 0.f; z[i] = w; }
#pragma unroll
    for (int s2 = 0; s2 < 2; ++s2) { const bf16x8 Pk = pack8(z, s2);
#pragma unroll
        for (int dd = 0; dd < 2; ++dd) O[dd] = mfma32(vfrag_perm_tr(Vh, loff, 32 * dd, 32 * kt + 16 * s2, h), Pk, O[dd]); }
    return R + run;
}
DI void sb_unit(ldsp lds, int u, const bf16_t* PROJ, bf16_t* MIXED, const float* gb, int tid) {
    tid = launder(tid);
    const int b = u >> 6, nb = u & 63;
    const size_t tok0 = (size_t)b * SEQ + (size_t)nb * 128;
    ldsp Ks = lds, VTs = lds + 73728; LAS int* flags = (LAS int*)(lds + 147456); LAS float* xs = (LAS float*)(lds + 147456 + 64);
    const int wave = __builtin_amdgcn_readfirstlane(tid >> 6), lane = tid & 63, p = wave & 3, hs = wave >> 2, qi = lane & 31, h = lane >> 5;
    const int loff = vt_lane_off(lane);
    bf16x8 q[2][4]; f32x16 O[2][2]; float R[2]; bool live[2];
#pragma unroll
    for (int it = 0; it < 2; ++it) { const int head = 2 * hs + it, rt = it ? 3 - p : p; const size_t token = tok0 + 32 * rt + qi;
#pragma unroll
        for (int kk = 0; kk < 4; ++kk) q[it][kk] = *(const bf16x8*)(PROJ + token * PW + C_QB + head * 64 + 16 * kk + 8 * h);
        O[it][0] = zero16(); O[it][1] = zero16(); R[it] = 0.f; live[it] = true; }
    int iter = 0;
    for (int kb = nb; kb >= 0; --kb) {
        __syncthreads();
        const size_t kt0 = (size_t)b * SEQ + (size_t)kb * 128;
        {   const int dsto[8] = {0, 18432, 36864, 55296, 73728, 73728 + 18432, 73728 + 36864, 73728 + 55296};
            const bf16_t* kp = PROJ + kt0 * PW + C_KB; const bf16_t* vp = PROJ + kt0 * PW + C_VB;
            const bf16_t* const srcs[8] = {kp, kp + 64, kp + 128, kp + 192, vp, vp + 64, vp + 128, vp + 192};
            const float lgs[8] = {0.f, 0.f, 0.f, 0.f, 0.f, 0.f, 0.f, 0.f};
            stage_tiles<8>(lds, dsto, srcs, lgs, tid); }
        __syncthreads();
#pragma unroll
        for (int it = 0; it < 2; ++it) {
            if (live[it]) { const int head = 2 * hs + it, rt = it ? 3 - p : p; ldsp Kh = Ks + head * 18432, Vh = VTs + head * 18432;
                for (int kt = (kb == nb) ? rt : 3; kt >= 0; --kt) {
                    R[it] = sb_tile(Kh, Vh, loff, q[it], O[it], R[it], kt, (kb == nb) && (kt == rt), qi, h);
                    if (__all(R[it] < SB_THR)) { live[it] = false; break; }
                }
            }
        }
        if (lane == 0) flags[(iter & 1) * 8 + wave] = (live[0] || live[1]) ? 1 : 0;
        __syncthreads();
        int any = 0;
#pragma unroll
        for (int w2 = 0; w2 < 8; ++w2) any |= flags[(iter & 1) * 8 + w2];
        ++iter;
        if (!any) break;
    }
#pragma unroll
    for (int it = 0; it < 2; ++it) { float ssq = 0.f;
#pragma unroll
        for (int dd = 0; dd < 2; ++dd)
#pragma unroll
            for (int i = 0; i < 16; ++i) ssq += O[it][dd][i] * O[it][dd][i];
        ssq += shx(ssq, 32);
        if (h == 0) xs[(2 * hs + it) * 128 + 32 * (it ? 3 - p : p) + qi] = ssq; }
    __syncthreads();
#pragma unroll
    for (int it = 0; it < 2; ++it) { const int head = 2 * hs + it, rt = it ? 3 - p : p, qrow = 32 * rt + qi; const size_t token = tok0 + qrow;
        const float rstd = rsqrtf(((xs[qrow] + xs[128 + qrow]) + (xs[256 + qrow] + xs[384 + qrow])) * (1.0f / 256.0f) + NORM_EPS);
#pragma unroll
        for (int dd = 0; dd < 2; ++dd)
#pragma unroll
            for (int g = 0; g < 4; ++g) { const int col = head * 64 + 32 * dd + 8 * g + 4 * h; const f32x4 gg = *(const f32x4*)(gb + col);
                u32x2 w; w.x = pk2(O[it][dd][4 * g] * rstd * gg[0], O[it][dd][4 * g + 1] * rstd * gg[1]); w.y = pk2(O[it][dd][4 * g + 2] * rstd * gg[2], O[it][dd][4 * g + 3] * rstd * gg[3]);
                *(u32x2*)(MIXED + token * D_MODEL + 384 + col) = w; } }
}

DI void ret_kv_load(u32x4 (&v)[4][2], int u2, const bf16_t* PROJ, int tid) {
    const int hp = u2 % 3, n = (u2 / 3) & 63, b = u2 / 192;
    const size_t tok0 = (size_t)b * SEQ + (size_t)n * 128;
    const bf16_t* kp = PROJ + tok0 * PW + C_KC + (2 * hp) * 64; const bf16_t* vp = PROJ + tok0 * PW + C_VC + (2 * hp) * 64;
    const int r0 = tid >> 3, c = tid & 7;
#pragma unroll
    for (int i = 0; i < 2; ++i) { const size_t ro = (size_t)(r0 + 64 * i) * PW + c * 8;
        v[0][i] = *(const u32x4*)(kp + ro); v[1][i] = *(const u32x4*)(kp + 64 + ro); v[2][i] = *(const u32x4*)(vp + ro); v[3][i] = *(const u32x4*)(vp + 64 + ro); }
}
DI void ret_kv_unit(ldsp lds, int u2, const u32x4 (&v)[4][2], float* KV, int tid) {
    const int hp = u2 % 3, n = (u2 / 3) & 63, b = u2 / 192;
    ldsp KTs = lds, VTs = lds + 36864;
    {   const int r0 = tid >> 3, c = tid & 7;
#pragma unroll
        for (int t = 0; t < 4; ++t)
#pragma unroll
            for (int i = 0; i < 2; ++i) { u32x4 o = v[t][i];
                if (t < 2) { const float sc = exp2f((float)(127 - (r0 + 64 * i)) * lg2gamma(2 * hp + t));
                    o.x = pk2(__uint_as_float(o.x << 16) * sc, __uint_as_float(o.x & 0xffff0000u) * sc); o.y = pk2(__uint_as_float(o.y << 16) * sc, __uint_as_float(o.y & 0xffff0000u) * sc);
                    o.z = pk2(__uint_as_float(o.z << 16) * sc, __uint_as_float(o.z & 0xffff0000u) * sc); o.w = pk2(__uint_as_float(o.w << 16) * sc, __uint_as_float(o.w & 0xffff0000u) * sc); }
                *(LAS u32x4*)(lds + t * 18432 + (r0 + 64 * i) * 144 + c * 16) = o; } }
}
DI void ret_kv_compute(ldsp lds, int u2, float* KV, int tid) {
    const int hp = u2 % 3, n = (u2 / 3) & 63, b = u2 / 192;
    ldsp KTs = lds, VTs = lds + 36864;
    const int wave = __builtin_amdgcn_readfirstlane(tid >> 6), lane = tid & 63, hs = wave >> 2, eh = (wave >> 1) & 1, dh = wave & 1, r = lane & 31, h = lane >> 5;
    const int head = 2 * hp + hs;
    f32x16 acc = zero16();
    const int loff = vt_lane_off(lane);
#pragma unroll
    for (int s = 0; s < 8; ++s) acc = mfma32(vfrag_nat_tr(VTs + hs * 18432, loff, 32 * eh, 16 * s, h), vfrag_nat_tr(KTs + hs * 18432, loff, 32 * dh, 16 * s, h), acc);
    float* base = KV + ((size_t)(b * 6 + head) * 64 + n) * 4096;
#pragma unroll
    for (int i = 0; i < 16; ++i) base[(32 * eh + crow(i, h)) * 64 + 32 * dh + r] = acc[i];
}
DI void ret_scan_phase(float* KV, int tid, int bid) {
    typedef float f32x2s __attribute__((ext_vector_type(2)));
    const int total2 = BATCH * 6 * 2048;
    for (int idx = bid * NTHREADS + tid; idx < total2; idx += gridDim.x * NTHREADS) {
        const int bh = idx >> 11, ed = (idx & 2047) * 2, head = bh % 6; const float cd = exp2f(128.0f * lg2gamma(head));
        float* p = KV + (size_t)bh * 64 * 4096 + ed; f32x2s s = {0.f, 0.f};
#pragma unroll 32
        for (int n = 0; n < 64; ++n) { const f32x2s t = *(const f32x2s*)(p + (size_t)n * 4096); *(f32x2s*)(p + (size_t)n * 4096) = s; s = s * cd + t; }
    }
}
DI void ret_out_unit(ldsp lds, int u2, const bf16_t* PROJ, const float* KV, bf16_t* MIXED, const float* gcn, int tid, const float* toutc) {
    tid = launder(tid);
    const int hp = u2 % 3, n = (u2 / 3) & 63, b = u2 / 192;
    const size_t tok0 = (size_t)b * SEQ + (size_t)n * 128;
    ldsp Ks = lds, VTs = lds + 36864;
    __syncthreads();
    {   const int dsto[4] = {0, 18432, 36864, 36864 + 18432};
        const bf16_t* kp = PROJ + tok0 * PW + C_KC + (2 * hp) * 64; const bf16_t* vp = PROJ + tok0 * PW + C_VC + (2 * hp) * 64;
        const bf16_t* const srcs[4] = {kp, kp + 64, vp, vp + 64};
        const float lgs[4] = {0.f, 0.f, 0.f, 0.f};
        stage_tiles<4>(lds, dsto, srcs, lgs, tid); }
    __syncthreads();
    const int wave = __builtin_amdgcn_readfirstlane(tid >> 6), lane = tid & 63, hs = wave >> 2, rt = wave & 3, qi = lane & 31, h = lane >> 5;
    const int head = 2 * hp + hs, qrow = 32 * rt + qi; const size_t token = tok0 + qrow;
    ldsp Kh = Ks + hs * 18432, Vh = VTs + hs * 18432; const int loff = vt_lane_off(lane);
    const float lg = lg2gamma(head);
    bf16x8 q[4];
#pragma unroll
    for (int kk = 0; kk < 4; ++kk) q[kk] = *(const bf16x8*)(PROJ + token * PW + C_QC + head * 64 + 16 * kk + 8 * h);
    f32x16 cross[2], intra[2];
    const float* ST = KV + ((size_t)(b * 6 + head) * 64 + n) * 4096;
#pragma unroll
    for (int eh = 0; eh < 2; ++eh) { cross[eh] = zero16(); intra[eh] = zero16();
#pragma unroll
        for (int kk = 0; kk < 4; ++kk) { const float* p = ST + (32 * eh + qi) * 64 + 16 * kk + 8 * h; const f32x4 a0 = *(const f32x4*)p, a1 = *(const f32x4*)(p + 4);
            u32x4 pa; pa.x = pk2(a0[0], a0[1]); pa.y = pk2(a0[2], a0[3]); pa.z = pk2(a1[0], a1[1]); pa.w = pk2(a1[2], a1[3]);
            cross[eh] = mfma32(__builtin_bit_cast(bf16x8, pa), q[kk], cross[eh]); } }
    for (int kt = 0; kt <= rt; ++kt) {
        f32x16 s = zero16();
#pragma unroll
        for (int kk = 0; kk < 4; ++kk) s = mfma32(kfrag(Kh, 32 * kt + qi, kk, h), q[kk], s);
        const int dbase = launder(qrow - 32 * kt - 4 * h);
#pragma unroll
        for (int i = 0; i < 16; ++i) { const int dlt = dbase - ((i & 3) + 8 * (i >> 2)); s[i] = dlt >= 0 ? s[i] * exp2f((float)dlt * lg) : 0.f; }
#pragma unroll
        for (int s2 = 0; s2 < 2; ++s2) { const bf16x8 Pk = pack8(s, s2);
#pragma unroll
            for (int dd = 0; dd < 2; ++dd) intra[dd] = mfma32(vfrag_perm_tr(Vh, loff, 32 * dd, 32 * kt + 16 * s2, h), Pk, intra[dd]); }
    }
    const float qdec = exp2f((float)(qrow + 1) * lg);
    float sum = 0.f;
#pragma unroll
    for (int dd = 0; dd < 2; ++dd)
#pragma unroll
        for (int i = 0; i < 16; ++i) { const float o = intra[dd][i] + qdec * cross[dd][i]; intra[dd][i] = o; sum += o; }
    sum += shx(sum, 32);
    const float mu = sum * (1.0f / 64.0f); float var = 0.f;
#pragma unroll
    for (int dd = 0; dd < 2; ++dd)
#pragma unroll
        for (int i = 0; i < 16; ++i) { const float d = intra[dd][i] - mu; intra[dd][i] = d; var += d * d; }
    var += shx(var, 32);
    const float rs = rsqrtf(var * (1.0f / 64.0f) + NORM_EPS);
#pragma unroll
    for (int dd = 0; dd < 2; ++dd)
#pragma unroll
        for (int g = 0; g < 4; ++g) { const int col = head * 64 + 32 * dd + 8 * g + 4 * h; const f32x4 gg = *(const f32x4*)(gcn + col);
            const u32x2 gt = *(const u32x2*)(PROJ + token * PW + C_GC + col);
            const float g0 = bf2f((unsigned short)(gt.x & 0xffffu)), g1 = bf2f((unsigned short)(gt.x >> 16)), g2 = bf2f((unsigned short)(gt.y & 0xffffu)), g3 = bf2f((unsigned short)(gt.y >> 16));
            const float o0 = intra[dd][4 * g] * rs * gg[0] * (g0 / (1.0f + __expf(-g0))), o1 = intra[dd][4 * g + 1] * rs * gg[1] * (g1 / (1.0f + __expf(-g1)));
            const float o2 = intra[dd][4 * g + 2] * rs * gg[2] * (g2 / (1.0f + __expf(-g2))), o3 = intra[dd][4 * g + 3] * rs * gg[3] * (g3 / (1.0f + __expf(-g3)));
            u32x2 w; w.x = pk2(o0, o1); w.y = pk2(o2, o3);
            if (n == 0 && qrow == 0) { const f32x4 ex = *(const f32x4*)(toutc + b * 384 + col); w.x = pk2(ex[0], ex[1]); w.y = pk2(ex[2], ex[3]); }
            *(u32x2*)(MIXED + token * D_MODEL + 640 + col) = w; }
}

constexpr size_t WS_T0 = 103 * MiB;
constexpr int T0_XM = 16384, T0_PROJ = 24576, T0_Y1 = 49152, T0_Y2 = 57344, T0_HT = 65536, T0_OUTC = 98304, T0_Y2P = 101376;
template <int KN> DI float t0_gemv16(const float* W, int N, int n0, const float* inT, ldsp redb, int tid) {
    const int cl = tid & 3, ks = tid >> 2;
    float acc[8][4];
#pragma unroll
    for (int r = 0; r < 8; ++r)
#pragma unroll
        for (int c = 0; c < 4; ++c) acc[r][c] = 0.f;
    const float* wp = W + (size_t)(ks * KN) * N + n0 + 4 * cl; const float* ip = inT + (size_t)(ks * KN) * 8;
#pragma unroll
    for (int k0 = 0; k0 < KN; k0 += 8) {
        f32x4 w[8];
#pragma unroll
        for (int k = 0; k < 8; ++k) w[k] = *(const f32x4*)(wp + (size_t)(k0 + k) * N);
#pragma unroll
        for (int k = 0; k < 8; ++k) { const f32x4 i0 = *(const f32x4*)(ip + (k0 + k) * 8), i1 = *(const f32x4*)(ip + (k0 + k) * 8 + 4);
#pragma unroll
            for (int r = 0; r < 4; ++r)
#pragma unroll
                for (int c = 0; c < 4; ++c) { acc[r][c] += i0[r] * w[k][c]; acc[4 + r][c] += i1[r] * w[k][c]; } } }
    LAS float* red = (LAS float*)redb;
#pragma unroll
    for (int r = 0; r < 8; ++r) *(LAS f32x4*)(red + (ks * 4 + cl) * 32 + r * 4) = (f32x4){acc[r][0], acc[r][1], acc[r][2], acc[r][3]};
    __syncthreads();
    float s = 0.f;
    if (tid < 128) { const int r = tid >> 4, c = tid & 15;
#pragma unroll 16
        for (int j = 0; j < 128; ++j) s += red[(j * 4 + (c >> 2)) * 32 + r * 4 + (c & 3)]; }
    __syncthreads();
    return s;
}
DI void t0_load_row(const float* p, int lane, f32x4 (&x)[4]) {
#pragma unroll
    for (int j = 0; j < 4; ++j) x[j] = *((const f32x4*)p + lane + 64 * j); }
DI float t0_ssq(const f32x4 (&x)[4]) { float s = 0.f;
#pragma unroll
    for (int j = 0; j < 4; ++j) s += (x[j][0] * x[j][0] + x[j][1] * x[j][1]) + (x[j][2] * x[j][2] + x[j][3] * x[j][3]);
    return wave_sum(s); }
DI void t0_put_inT(LAS float* inT, const f32x4 (&x)[4], const float* g, int lane, int r) {
#pragma unroll
    for (int j = 0; j < 4; ++j) { const f32x4 gg = *((const f32x4*)g + lane + 64 * j);
#pragma unroll
        for (int e = 0; e < 4; ++e) inT[(lane * 4 + 256 * j + e) * 8 + r] = x[j][e] * gg[e]; } }
DI void t0_store_row(float* p, int lane, const f32x4 (&x)[4]) {
#pragma unroll
    for (int j = 0; j < 4; ++j) *((f32x4*)p + lane + 64 * j) = x[j]; }
DI void t0_stage1(unsigned char* ldsg, unsigned char* ws, int l, int tb, const float* xin, const float* w_in_l, const float* g_post_prev, const float* g_pre, int tid) {
    tid = launder(tid);
    float* T = (float*)(ws + WS_T0); const int r = tid >> 6, lane = tid & 63;
    LAS float* inT = (LAS float*)(ldsp)ldsg; LAS float* rs = (LAS float*)((ldsp)ldsg + 98304);
    f32x4 x[4];
    if (l == 0) t0_load_row(xin + (size_t)r * SEQ * D_MODEL, lane, x);
    else { f32x4 y[4], y1[4]; t0_load_row(T + T0_XM + r * 1024, lane, x);
        t0_load_row(T + T0_Y2P + r * 1024, lane, y); t0_load_row(T + T0_Y2P + 8192 + r * 1024, lane, y1);
#pragma unroll
        for (int j = 0; j < 4; ++j) y[j] = y[j] + y1[j];
        t0_load_row(T + T0_Y2P + 16384 + r * 1024, lane, y1);
#pragma unroll
        for (int j = 0; j < 4; ++j) y[j] = y[j] + y1[j];
        t0_load_row(T + T0_Y2P + 24576 + r * 1024, lane, y1);
#pragma unroll
        for (int j = 0; j < 4; ++j) y[j] = y[j] + y1[j];
        const float rstd = rsqrtf(t0_ssq(y) * (1.0f / D_MODEL) + NORM_EPS);
#pragma unroll
        for (int j = 0; j < 4; ++j) x[j] = x[j] + y[j] * rstd * *((const f32x4*)g_post_prev + lane + 64 * j); }
    const float rstdx = rsqrtf(t0_ssq(x) * (1.0f / D_MODEL) + NORM_EPS);
    if (lane == 0) rs[r] = rstdx;
    t0_put_inT(inT, x, g_pre, lane, r);
    if (tb == 0) t0_store_row(T + (l & 1) * 8192 + r * 1024, lane, x);
    __syncthreads();
    const float s = t0_gemv16<8>(w_in_l, IN_W, 16 * tb, (const float*)ldsg, (ldsp)ldsg + 32768, tid);
    if (tid < 128) T[T0_PROJ + (tid >> 4) * 3072 + 16 * tb + (tid & 15)] = s * rs[tid >> 4];
    __syncthreads();
}
DI void t0_stage2(unsigned char* ldsg, unsigned char* ws, int l, int tb, const float* w_out_l, const float* sinks_l, const float* bg, const float* rope_c, const float* rope_s, int tid) {
    tid = launder(tid);
    float* T = (float*)(ws + WS_T0); const int r = tid >> 6, lane = tid & 63;
    LAS float* inT = (LAS float*)(ldsp)ldsg; const float* P = T + T0_PROJ + r * 3072;
    const float cc = rope_c[lane & 31], ss = rope_s[lane & 31];
#define T0_ROPE(v, dst) { const float v_ = (v), o_ = shx(v_, 32); dst = (lane < 32) ? (v_ * cc - o_ * ss) : (o_ * ss + v_ * cc); }
    float outa[6]; float ssqA = 0.f;
#pragma unroll
    for (int kv = 0; kv < 2; ++kv) { float ka; T0_ROPE(P[C_KA + kv * 64 + lane], ka); const float va = P[C_VA + kv * 64 + lane];
#pragma unroll
        for (int g = 0; g < 3; ++g) { const int h = 3 * kv + g; float qa; T0_ROPE(P[C_QA + h * 64 + lane], qa);
            const float sc = wave_sum(qa * ka) * 0.125f, sink = sinks_l[h], mx = fmaxf(sc, sink), e1 = expf(sc - mx), e2 = expf(sink - mx);
            outa[h] = (e1 / (e1 + e2)) * va; ssqA += outa[h] * outa[h]; } }
    const float rstdA = rsqrtf(wave_sum(ssqA) * (1.0f / 384.0f) + NORM_EPS);
#pragma unroll
    for (int h = 0; h < 6; ++h) inT[(h * 64 + lane) * 8 + r] = outa[h] * rstdA * bg[h * 64 + lane];
#pragma unroll
    for (int h = 0; h < 4; ++h) inT[(384 + h * 64 + lane) * 8 + r] = 0.f;
#pragma unroll
    for (int h = 0; h < 6; ++h) { float qc, kc; T0_ROPE(P[C_QC + h * 64 + lane], qc); T0_ROPE(P[C_KC + h * 64 + lane], kc);
        const float c = wave_sum(qc * kc) * 0.125f, o = c * P[C_VC + h * 64 + lane], mu = wave_sum(o) * (1.0f / 64.0f), d = o - mu, var = wave_sum(d * d) * (1.0f / 64.0f);
        const float gt = P[C_GC + h * 64 + lane], oc = d * rsqrtf(var + NORM_EPS) * bg[640 + h * 64 + lane] * (gt / (1.0f + expf(-gt)));
        inT[(640 + h * 64 + lane) * 8 + r] = oc;
        if (tb == 0) T[T0_OUTC + r * 384 + h * 64 + lane] = oc; }
#undef T0_ROPE
    __syncthreads();
    const float s = t0_gemv16<8>(w_out_l, D_MODEL, 16 * tb, (const float*)ldsg, (ldsp)ldsg + 32768, tid);
    if (tid < 128) T[T0_Y1 + (tid >> 4) * 1024 + 16 * tb + (tid & 15)] = s;
    __syncthreads();
}
DI void t0_stage3(unsigned char* ldsg, unsigned char* ws, int l, int tb, const float* w_up_l, const float* g_post, const float* g_pre, int tid) {
    tid = launder(tid);
    float* T = (float*)(ws + WS_T0); const int r = tid >> 6, lane = tid & 63;
    LAS float* inT = (LAS float*)(ldsp)ldsg; LAS float* rs = (LAS float*)((ldsp)ldsg + 98304);
    f32x4 x[4], y[4]; t0_load_row(T + (l & 1) * 8192 + r * 1024, lane, x); t0_load_row(T + T0_Y1 + r * 1024, lane, y);
    const float rstd = rsqrtf(t0_ssq(y) * (1.0f / D_MODEL) + NORM_EPS);
#pragma unroll
    for (int j = 0; j < 4; ++j) x[j] = x[j] + y[j] * rstd * *((const f32x4*)g_post + lane + 64 * j);
    const float rstdx = rsqrtf(t0_ssq(x) * (1.0f / D_MODEL) + NORM_EPS);
    if (lane == 0) rs[r] = rstdx;
    t0_put_inT(inT, x, g_pre, lane, r);
    if (tb == 0) t0_store_row(T + T0_XM + r * 1024, lane, x);
    __syncthreads();
    const float s = t0_gemv16<8>(w_up_l, D_FF, 16 * tb, (const float*)ldsg, (ldsp)ldsg + 32768, tid);
    if (tid < 128) { const float v = fmaxf(s * rs[tid >> 4], 0.f); T[T0_HT + (16 * tb + (tid & 15)) * 8 + (tid >> 4)] = v * v; }
    __syncthreads();
}
DI void t0_stage4(unsigned char* ldsg, unsigned char* ws, int tb, const float* w_down_l, int tid) {
    tid = launder(tid);
    float* T = (float*)(ws + WS_T0);
    const int cb = tb & 63, kq = tb >> 6;
    const float s = t0_gemv16<8>(w_down_l + (size_t)kq * 1024 * D_MODEL, D_MODEL, 16 * cb, T + T0_HT + kq * 8192, (ldsp)ldsg + 32768, tid);
    if (tid < 128) T[T0_Y2P + kq * 8192 + (tid >> 4) * 1024 + 16 * cb + (tid & 15)] = s;
    __syncthreads();
}

DI f32x4 unpk4(u32x2 w) { f32x4 r; r[0] = __uint_as_float(w.x << 16); r[1] = __uint_as_float(w.x & 0xffff0000u); r[2] = __uint_as_float(w.y << 16); r[3] = __uint_as_float(w.y & 0xffff0000u); return r; }
template <bool SRC_BF, bool DST_BF>
DI void norm_res_phase(const void* xsrc_, const bf16_t* Y, const float* gpost, const float* gpre, void* xout_, bf16_t* XN, int tid, int bid) {
    constexpr int NR = 4;
    const int wave = tid >> 6, lane = tid & 63, NW = gridDim.x * NWAVES;
    for (int row0 = bid * NWAVES + wave; row0 < M_TOK; row0 += NR * NW) {
        f32x4 xf[SRC_BF ? 1 : NR][4]; u32x2 xraw[SRC_BF ? NR : 1][4]; u32x2 yraw[NR][4];
#pragma unroll
        for (int r = 0; r < NR; ++r) { const size_t row = (size_t)row0 + (size_t)r * NW;
            if (SRC_BF) { const u32x2* xr = (const u32x2*)((const bf16_t*)xsrc_ + row * D_MODEL) + lane;
#pragma unroll
                for (int j = 0; j < 4; ++j) xraw[SRC_BF ? r : 0][j] = xr[64 * j];
            } else { const f32x4* xr = (const f32x4*)((const float*)xsrc_ + row * D_MODEL) + lane;
#pragma unroll
                for (int j = 0; j < 4; ++j) xf[SRC_BF ? 0 : r][j] = xr[64 * j]; }
            if (Y) { const u32x2* yr = (const u32x2*)(Y + row * D_MODEL) + lane;
#pragma unroll
                for (int j = 0; j < 4; ++j) yraw[r][j] = yr[64 * j]; } }
        f32x4 gp[4], gq[4];
        if (Y) {
#pragma unroll
            for (int j = 0; j < 4; ++j) gp[j] = *((const f32x4*)gpost + lane + 64 * j); }
        if (XN) {
#pragma unroll
            for (int j = 0; j < 4; ++j) gq[j] = *((const f32x4*)gpre + lane + 64 * j); }
#pragma unroll
        for (int r = 0; r < NR; ++r) { const size_t row = (size_t)row0 + (size_t)r * NW;
            f32x4 v[4];
#pragma unroll
            for (int j = 0; j < 4; ++j) v[j] = SRC_BF ? unpk4(xraw[SRC_BF ? r : 0][j]) : xf[SRC_BF ? 0 : r][j];
            if (Y) { f32x4 y[4]; float s = 0.f;
#pragma unroll
                for (int j = 0; j < 4; ++j) { y[j] = unpk4(yraw[r][j]); s += (y[j][0] * y[j][0] + y[j][1] * y[j][1]) + (y[j][2] * y[j][2] + y[j][3] * y[j][3]); }
                const float rstd = rsqrtf(wave_sum(s) * (1.0f / D_MODEL) + NORM_EPS);
#pragma unroll
                for (int j = 0; j < 4; ++j) v[j] = v[j] + y[j] * rstd * gp[j]; }
            if (xout_) {
                if (DST_BF) { u32x2* xo = (u32x2*)((bf16_t*)xout_ + row * D_MODEL) + lane;
#pragma unroll
                    for (int j = 0; j < 4; ++j) { u32x2 w; w.x = pk2(v[j][0], v[j][1]); w.y = pk2(v[j][2], v[j][3]); xo[64 * j] = w;
                        v[j] = unpk4(w); }
                } else { f32x4* xo = (f32x4*)((float*)xout_ + row * D_MODEL) + lane;
#pragma unroll
                    for (int j = 0; j < 4; ++j) xo[64 * j] = v[j]; } }
            if (XN) { float s = 0.f;
#pragma unroll
                for (int j = 0; j < 4; ++j) s += (v[j][0] * v[j][0] + v[j][1] * v[j][1]) + (v[j][2] * v[j][2] + v[j][3] * v[j][3]);
                const float rstd = rsqrtf(wave_sum(s) * (1.0f / D_MODEL) + NORM_EPS);
                u32x2* xo = (u32x2*)(XN + row * D_MODEL) + lane;
#pragma unroll
                for (int j = 0; j < 4; ++j) { const f32x4 o = v[j] * rstd * gq[j]; u32x2 w; w.x = pk2(o[0], o[1]); w.y = pk2(o[2], o[3]); xo[64 * j] = w; } }
        }
    }
}
template <int MODE> DI void transpose_item(const float* W, int K, int Nsrc, int Ndst, bf16_t* WT, LAS float* scr, int item, int lane, const float* gk) {
    const int nblk = Ndst / 32, kb = item / nblk, nbk = item % nblk, k0 = 64 * kb, n0 = 32 * nbk;
    const int nd = n0 + (lane & 31); int src = nd; float sc = 1.f; bool ok = true;
    if (MODE == 1) { const int head = nd >> 6, p = nd & 63; const bool rope = (head < 8) || (head >= 22 && head < 34);
        const int f = rope ? (4 * (p >> 3) + (p & 3) + 32 * ((p >> 2) & 1)) : p; ok = nd < IN_W; src = ok ? head * 64 + f : 0;
        sc = ((head < 6) || (head >= 10 && head < 14) || (head >= 28 && head < 34)) ? 0.125f : 1.f; }
#pragma unroll
    for (int i = 0; i < 32; ++i) { const int kk = 2 * i + (lane >> 5); scr[kk * 33 + (lane & 31)] = ok ? W[(size_t)(k0 + kk) * Nsrc + src] * (gk ? sc * gk[k0 + kk] : sc) : 0.f; }
    LDS_WAIT();
    const int c = lane & 7;
#pragma unroll
    for (int j = 0; j < 4; ++j) { const int n = (lane >> 3) + 8 * j; const LAS float* s = scr + (8 * c) * 33 + n;
        u32x4 o; o.x = pk2(s[0 * 33], s[1 * 33]); o.y = pk2(s[2 * 33], s[3 * 33]); o.z = pk2(s[4 * 33], s[5 * 33]); o.w = pk2(s[6 * 33], s[7 * 33]);
        *(u32x4*)(WT + (size_t)(n0 + n) * K + k0 + 8 * c) = o; }
    LDS_WAIT();
}

#ifdef DUP_MIX
#define MIXREP 2
#else
#define MIXREP 1
#endif
#ifdef DUP_P2
#define MIXREP2 2
#else
#define MIXREP2 MIXREP
#endif
struct Args { const float* x; const int* positions; const float* w_in; const float* w_out; const float* sinks; const float* branch_gain; const float* w_up; const float* w_down;
              const float* g_mix_pre; const float* g_mix_post; const float* g_mlp_pre; const float* g_mlp_post; float* out; unsigned char* ws; int ph_lo, ph_hi; };

__global__ void __launch_bounds__(NTHREADS, 2) fwd_kernel(Args a) {
    extern __shared__ __attribute__((aligned(16))) unsigned char lds_raw[];
    ldsp lds = (ldsp)lds_raw;
    cg::grid_group grid = cg::this_grid();
    const int G = gridDim.x;
    unsigned char* ws = a.ws;
    float* ROPE_C = (float*)(ws + WS_ROPE); float* ROPE_S = ROPE_C + SEQ * 32;
    bf16_t* XN = (bf16_t*)(ws + WS_XN); bf16_t* Y = (bf16_t*)(ws + WS_Y); bf16_t* PROJ = (bf16_t*)(ws + WS_PROJ); bf16_t* MIXED = (bf16_t*)(ws + WS_MIXED); bf16_t* H = (bf16_t*)(ws + WS_H); bf16_t* XB = (bf16_t*)(ws + WS_XB); float* PS1 = (float*)(ws + WS_PS1); float* PS2 = (float*)(ws + WS_PS2); unsigned* CNT = (unsigned*)(ws + WS_CNT);
    float* KV = (float*)(ws + WS_KV);
    volatile LAS unsigned* MISC = (volatile LAS unsigned*)(lds + 155392);
    if (threadIdx.x < 16) MISC[threadIdx.x] = 0u;
    __syncthreads();
    const XcdBarrier xbar = xcd_barrier_post((unsigned*)ws + 4096, MISC + 8);
    const int lo = a.ph_lo, hi = a.ph_hi;
    for (int ph = lo; ph < hi; ++ph) {
        int tid_l = threadIdx.x, bid_l = blockIdx.x; asm volatile("" : "+v"(tid_l)); asm volatile("" : "+s"(bid_l));
        const int tid = tid_l, bid = bid_l, wave = __builtin_amdgcn_readfirstlane(tid >> 6), lane = tid & 63;
        if (ph == 0) {
#ifdef DUP_P0
            for (int rep0_ = 0; rep0_ < 2; ++rep0_) {
#endif
            for (int idx = bid * NTHREADS + tid; idx < SEQ * 32; idx += G * NTHREADS) { const int s = idx >> 5, i = idx & 31;
                const float inv = powf(10000.0f, -(float)(2 * i) / 64.0f), ang = (float)a.positions[s] * inv; ROPE_C[idx] = cosf(ang); ROPE_S[idx] = sinf(ang); }
            LAS float* scr = (LAS float*)(lds + wave * 16384);
            constexpr int I_IN = 16 * 96, I_OUT = 16 * 32, I_UP = 16 * 128, I_DN = 64 * 32, I_L = I_IN + I_OUT + I_UP + I_DN;
            for (int it = bid * NWAVES + wave; it < DEPTH * I_L; it += G * NWAVES) {
                const int l = it / I_L; int r = it % I_L; unsigned char* wl = ws + WS_W + (size_t)l * W_LAYER;
                if (r < I_IN) { transpose_item<1>(a.w_in + (size_t)l * D_MODEL * IN_W, D_MODEL, IN_W, PW, (bf16_t*)wl, scr, r, lane, a.g_mix_pre + l * D_MODEL); continue; } r -= I_IN;
                if (r < I_OUT) { transpose_item<0>(a.w_out + (size_t)l * D_MODEL * D_MODEL, D_MODEL, D_MODEL, D_MODEL, (bf16_t*)(wl + W_OUT_OFF), scr, r, lane, nullptr); continue; } r -= I_OUT;
                if (r < I_UP) { transpose_item<0>(a.w_up + (size_t)l * D_MODEL * D_FF, D_MODEL, D_FF, D_FF, (bf16_t*)(wl + W_UP_OFF), scr, r, lane, a.g_mlp_pre + l * D_MODEL); continue; } r -= I_UP;
                transpose_item<0>(a.w_down + (size_t)l * D_FF * D_MODEL, D_FF, D_MODEL, D_MODEL, (bf16_t*)(wl + W_DOWN_OFF), scr, r, lane, nullptr);
            }
            for (int idx = bid * NTHREADS + tid; idx < DEPTH * 4 * D_MODEL; idx += G * NTHREADS) { const int l = idx >> 12, w = (idx >> 10) & 3, c = idx & 1023;
                const float* srcg = (w == 0) ? a.g_mix_pre : (w == 1) ? a.g_mix_post : (w == 2) ? a.g_mlp_pre : a.g_mlp_post; ((float*)(ws + WS_GAIN))[idx] = srcg[l * D_MODEL + c]; }
            for (int row0 = bid * NWAVES + wave; row0 < M_TOK; row0 += 4 * G * NWAVES) {
                f32x4 v[4][4];
#pragma unroll
                for (int r = 0; r < 4; ++r) { const f32x4* xr = (const f32x4*)(a.x + ((size_t)row0 + (size_t)r * G * NWAVES) * D_MODEL) + lane;
#pragma unroll
                    for (int j = 0; j < 4; ++j) v[r][j] = xr[64 * j]; }
#pragma unroll
                for (int r = 0; r < 4; ++r) { const size_t row = (size_t)row0 + (size_t)r * G * NWAVES; float s = 0.f;
#pragma unroll
                    for (int j = 0; j < 4; ++j) s += (v[r][j][0] * v[r][j][0] + v[r][j][1] * v[r][j][1]) + (v[r][j][2] * v[r][j][2] + v[r][j][3] * v[r][j][3]);
#pragma unroll
                    for (int j = 0; j < 4; ++j) { u32x2 wb; wb.x = pk2(v[r][j][0], v[r][j][1]); wb.y = pk2(v[r][j][2], v[r][j][3]); ((u32x2*)(XB + row * D_MODEL) + lane)[64 * j] = wb; }
                    s = wave_sum(s);
                    if (lane == 0) *(f32x4*)(PS2 + row * 4) = (f32x4){s, 0.f, 0.f, 0.f}; }
            }
            __syncthreads();
#ifdef DUP_P0
            }
#endif
        } else {
            const int l = (ph - 1) / 7, k = (ph - 1) % 7;
            unsigned char* wl = ws + WS_W + (size_t)l * W_LAYER;
            const float* bg = a.branch_gain + l * D_MODEL;
            if (k == 0 && bid < 184) t0_stage1(lds_raw, ws, l, bid, a.x, a.w_in + (size_t)l * D_MODEL * IN_W, a.g_mlp_post + (l > 0 ? l - 1 : 0) * D_MODEL, a.g_mix_pre + l * D_MODEL, tid);
            if (k == 2 && bid >= 192) t0_stage2(lds_raw, ws, l, bid - 192, a.w_out + (size_t)l * D_MODEL * D_MODEL, a.sinks + l * 6, bg, ROPE_C, ROPE_S, tid);
            if (k == 3) t0_stage3(lds_raw, ws, l, bid, a.w_up + (size_t)l * D_MODEL * D_FF, a.g_mix_post + l * D_MODEL, a.g_mlp_pre + l * D_MODEL, tid);
            if (k == 4 && bid < 256) t0_stage4(lds_raw, ws, bid, a.w_down + (size_t)l * D_FF * D_MODEL, tid);
            if (k == 0 || k >= 4) {
                const bf16_t* A = XB; const bf16_t* Bt = (const bf16_t*)wl; int N = PW, K = D_MODEL;
                int mode = 2;
                if (k == 4) { A = MIXED; Bt = (const bf16_t*)(wl + W_OUT_OFF); N = D_MODEL; mode = 3; }
                if (k == 5) { Bt = (const bf16_t*)(wl + W_UP_OFF); N = D_FF; mode = 1; }
                if (k == 6) { A = H; Bt = (const bf16_t*)(wl + W_DOWN_OFF); N = D_MODEL; K = D_FF; mode = 4; }
                pg8::EpiAny E{ws, a.x, a.out, mode, l};
                pg8::Gemm g{A, Bt, M_TOK, N, K}; pg8::StaticOrder S; S.init(M_TOK, N, G, bid);
                pg8::gemm_phase<pg8::EpiAny, pg8::StaticOrder, PG8_ALIGN, PG8_SP2>(lds, g, S, E, tid);
            } else if (k == 1) {
                int u_ = (G == 256) ? ((bid & 7) * 32 + (bid >> 3)) : bid;
                for (; u_ < 512; u_ += G) swa_unit(lds, u_, PROJ, MIXED, a.sinks + l * 6, bg, tid);
                {
                    const int tl = launder(tid);
                    u32x4 pre[4][2];
#pragma unroll
                    for (int t_ = 0; t_ < 4; ++t_) { pre[t_][0] = (u32x4){0u, 0u, 0u, 0u}; pre[t_][1] = (u32x4){0u, 0u, 0u, 0u}; }
                    if (u_ < 2048) ret_kv_load(pre, u_ - 512, PROJ, tl);
                    for (; u_ < 2048; u_ += G) {
                        __syncthreads();
                        ret_kv_unit(lds, u_ - 512, pre, KV, tl);
                        __syncthreads();
                        if (u_ + G < 2048) ret_kv_load(pre, u_ + G - 512, PROJ, tl);
                        ret_kv_compute(lds, u_ - 512, KV, tl);
                    }
                }
                __syncthreads();
            } else if (k == 2) {
                ret_scan_phase(KV, tid, bid);
            } else {
                for (int u_ = (G == 256) ? ((bid & 7) * 32 + (bid >> 3)) : bid; u_ < 2048; u_ += G) { const int u = u_;
                    if (u < 512) sb_unit(lds, u, PROJ, MIXED, bg + 384, tid);
                    else ret_out_unit(lds, u - 512, PROJ, KV, MIXED, bg + 640, tid, (const float*)(ws + WS_T0) + T0_OUTC);
                }
                __syncthreads();
            }
        }
        if (ph + 1 < hi) { if (ph == lo) grid.sync(); else xcd_barrier(xbar); }
    }
}

extern "C" void kernel_launch(void* const* d_in, const int* in_sizes, int n_in, void* d_out, int out_size, void* d_ws, size_t ws_size, hipStream_t stream) {
    static int grid = 0;
    if (grid == 0) {
        if (n_in != 12 || in_sizes[0] != M_TOK * D_MODEL || out_size != M_TOK * D_MODEL || ws_size < WS_END) { fprintf(stderr, "kernel_launch: unexpected shapes (n_in %d in0 %d out %d ws %zu)\n", n_in, n_in > 0 ? in_sizes[0] : -1, out_size, ws_size); grid = -1; return; }
        int dev = 0, cus = 0, per_cu = 0;
        if (hipGetDevice(&dev) != hipSuccess || hipDeviceGetAttribute(&cus, hipDeviceAttributeMultiprocessorCount, dev) != hipSuccess) { grid = -1; return; }
        if (hipFuncSetAttribute((const void*)fwd_kernel, hipFuncAttributeMaxDynamicSharedMemorySize, LDS_BYTES) != hipSuccess) { fprintf(stderr, "kernel_launch: hipFuncSetAttribute failed\n"); grid = -1; return; }
        if (hipOccupancyMaxActiveBlocksPerMultiprocessor(&per_cu, (const void*)fwd_kernel, NTHREADS, LDS_BYTES) != hipSuccess || per_cu < 1) fprintf(stderr, "kernel_launch: occupancy query reports %d\n", per_cu);
        (void)hipGetLastError();
        grid = cus;
    }
    if (grid < 0) return;
    if (hipMemsetAsync(d_ws, 0, 262144, stream) != hipSuccess) { fprintf(stderr, "kernel_launch: memset of the barrier words failed\n"); return; }
    Args a{};
    a.x = (const float*)d_in[0]; a.positions = (const int*)d_in[1]; a.w_in = (const float*)d_in[2]; a.w_out = (const float*)d_in[3]; a.sinks = (const float*)d_in[4]; a.branch_gain = (const float*)d_in[5];
    a.w_up = (const float*)d_in[6]; a.w_down = (const float*)d_in[7]; a.g_mix_pre = (const float*)d_in[8]; a.g_mix_post = (const float*)d_in[9]; a.g_mlp_pre = (const float*)d_in[10]; a.g_mlp_post = (const float*)d_in[11];
    a.out = (float*)d_out; a.ws = (unsigned char*)d_ws; a.ph_lo = 0; a.ph_hi = 1 + 7 * DEPTH;
    void* args[] = {&a};
    hipError_t e = hipLaunchCooperativeKernel((const void*)fwd_kernel, dim3(grid), dim3(NTHREADS), args, LDS_BYTES, stream);
    if (e != hipSuccess) fprintf(stderr, "kernel_launch: cooperative launch failed: %s (grid %d)\n", hipGetErrorString(e), grid);
}
```
